# Optimizing an MI355X kernel written in HIP

```python
import functools
import jax, jax.numpy as jnp
from jax import lax
import numpy as np

D_MODEL = 1024
BATCH = 8
SEQ = 4096
DEPTH = 1
DEC_BATCH = 16
DEC_SEQ = 16
PAST_LEN = 1024

CHUNK = 64
WINDOW = 128
WINDOW_CHUNKS = WINDOW // CHUNK
HEAD_DIM = 64
N_HEADS = 16
N_KV_HEADS = 4
Q_PER_KV = N_HEADS // N_KV_HEADS
D_ATTN = N_HEADS * HEAD_DIM
D_KV = N_KV_HEADS * HEAD_DIM
SCALE = HEAD_DIM ** -0.5
SSM_HEADS = 16
SSM_HEAD_DIM = 64
SSM_GROUPS = 4
HEADS_PER_GROUP = SSM_HEADS // SSM_GROUPS
SSM_STATE = 128
D_SSM = SSM_HEADS * SSM_HEAD_DIM
CONV_WIDTH = 4
CONV_DIM = D_SSM + 2 * SSM_GROUPS * SSM_STATE
D_MIX = D_ATTN + D_SSM
IN_SPLITS = (D_ATTN, D_ATTN + D_KV, D_ATTN + 2 * D_KV, D_ATTN + 2 * D_KV + D_SSM,
             D_ATTN + 2 * D_KV + D_SSM + CONV_DIM)
D_IN = D_ATTN + 2 * D_KV + D_SSM + CONV_DIM + SSM_HEADS
D_FF = -(-8 * D_MODEL // (3 * 256)) * 256
EPS = 1e-6

kernel_name = 'hymba_swa_sink_ssd_stream_step'


def rmsnorm(x, g):
    xf = x.astype(jnp.float32)
    xf = xf * lax.rsqrt(jnp.mean(xf * xf, axis=-1, keepdims=True) + EPS)
    return xf.astype(x.dtype) * g


def gated_group_rmsnorm(y, z, w):
    g = y.astype(jnp.float32) * jax.nn.silu(z.astype(jnp.float32))
    gg = g.reshape(*g.shape[:-1], SSM_GROUPS, D_SSM // SSM_GROUPS)
    gg = gg * lax.rsqrt(jnp.mean(gg * gg, axis=-1, keepdims=True) + EPS)
    return gg.reshape(g.shape) * w.astype(jnp.float32)


def sink_softmax(scores, sinks):
    sink = sinks.astype(jnp.float32).reshape(N_KV_HEADS, Q_PER_KV, 1, 1)
    m = jnp.maximum(scores.max(axis=-1, keepdims=True), sink)
    p = jnp.exp(scores - m)
    return p / (p.sum(axis=-1, keepdims=True) + jnp.exp(sink - m))


def window_attention_prompt(q, k, v, sinks):
    b, s = q.shape[:2]
    nc = s // CHUNK
    qc = q.reshape(b, nc, CHUNK, N_KV_HEADS, Q_PER_KV, HEAD_DIM)
    pad = ((0, 0), (WINDOW, 0), (0, 0), (0, 0))
    kp = jnp.pad(k, pad).reshape(b, nc + WINDOW_CHUNKS, CHUNK, N_KV_HEADS, HEAD_DIM)
    vp = jnp.pad(v, pad).reshape(b, nc + WINDOW_CHUNKS, CHUNK, N_KV_HEADS, HEAD_DIM)
    kb = jnp.concatenate([kp[:, j:j + nc] for j in range(WINDOW_CHUNKS + 1)], axis=2)
    vb = jnp.concatenate([vp[:, j:j + nc] for j in range(WINDOW_CHUNKS + 1)], axis=2)
    key_chunk = jnp.arange(nc)[:, None] + jnp.arange(-WINDOW_CHUNKS, 1)[None, :]
    valid = jnp.repeat(key_chunk >= 0, CHUNK, axis=1)
    scores = jnp.einsum('bcqkgd,bcskd->bckgqs', qc, kb, preferred_element_type=jnp.float32) * SCALE
    scores = jnp.where(valid[None, :, None, None, None, :], scores, -jnp.inf)
    p = sink_softmax(scores, sinks).astype(vb.dtype)
    o = jnp.einsum('bckgqs,bcskd->bcqkgd', p, vb)
    return o.reshape(b, s, D_ATTN)


def window_attention_sample(q, k, v, past_k, past_v, sinks):
    b, t = q.shape[:2]
    kk = jnp.concatenate([past_k.astype(k.dtype), k], axis=1)
    vv = jnp.concatenate([past_v.astype(v.dtype), v], axis=1)
    qg = q.reshape(b, t, N_KV_HEADS, Q_PER_KV, HEAD_DIM)
    scores = jnp.einsum('btkgd,bskd->bkgts', qg, kk, preferred_element_type=jnp.float32) * SCALE
    p = sink_softmax(scores, sinks).astype(vv.dtype)
    o = jnp.einsum('bkgts,bskd->btkgd', p, vv)
    return o.reshape(b, t, D_ATTN)


def causal_conv(xbc, buf, conv_w, conv_b):
    t = xbc.shape[1]
    xx = jnp.concatenate([buf.astype(xbc.dtype), xbc], axis=1)
    y = sum((xx[:, i:i + t] * conv_w[i] for i in range(CONV_WIDTH)), conv_b)
    return jax.nn.silu(y), xx[:, t:]


def ssd_scan(x, dt, a_log, bm, cm, h0, chunk):
    b, L = x.shape[:2]
    nc = L // chunk
    R = HEADS_PER_GROUP
    a = -jnp.exp(a_log.astype(jnp.float32))
    da = (dt * a).reshape(b, nc, chunk, SSM_GROUPS, R)
    xd = (x.astype(jnp.float32) * dt[..., None]).reshape(b, nc, chunk, SSM_GROUPS, R, SSM_HEAD_DIM)
    bc = bm.astype(jnp.float32).reshape(b, nc, chunk, SSM_GROUPS, SSM_STATE)
    cc = cm.astype(jnp.float32).reshape(b, nc, chunk, SSM_GROUPS, SSM_STATE)
    cs = jnp.cumsum(da, axis=2)
    causal = jnp.tril(jnp.ones((chunk, chunk), dtype=bool))[:, :, None, None]
    lmat = jnp.exp(jnp.where(causal, cs[:, :, :, None] - cs[:, :, None, :], -jnp.inf))
    cb = jnp.einsum('bclgn,bcsgn->bclsg', cc, bc)
    y_diag = jnp.einsum('bclsgr,bcsgrp->bclgrp', cb[..., None] * lmat, xd)
    decay = jnp.exp(cs[:, :, -1:] - cs)
    states = jnp.einsum('bclgn,bclgrp->bcgrpn', bc, xd * decay[..., None])
    chunk_decay = jnp.exp(cs[:, :, -1])

    def step(h, inp):
        s_c, d_c = inp
        return d_c[..., None, None] * h + s_c, h

    h_init = h0.astype(jnp.float32).reshape(b, SSM_GROUPS, R, SSM_HEAD_DIM, SSM_STATE)
    h_last, h_prev = lax.scan(step, h_init, (jnp.moveaxis(states, 1, 0), jnp.moveaxis(chunk_decay, 1, 0)))
    h_prev = jnp.moveaxis(h_prev, 0, 1)
    y_off = jnp.einsum('bclgn,bcgrpn->bclgrp', cc, h_prev) * jnp.exp(cs)[..., None]
    y = (y_diag + y_off).reshape(b, L, SSM_HEADS, SSM_HEAD_DIM)
    return y, h_last.reshape(b, SSM_HEADS, SSM_HEAD_DIM, SSM_STATE)


def hybrid_mixer(u, past_k, past_v, conv_buf, h0, w_in, conv_w, conv_b, dt_bias, a_log, d_skip,
                 ssm_norm_w, sinks, w_out):
    b, t, _ = u.shape
    q, k, v, z, xbc, dt_raw = jnp.split(u @ w_in, IN_SPLITS, axis=-1)
    q = q.reshape(b, t, N_HEADS, HEAD_DIM)
    k = k.reshape(b, t, N_KV_HEADS, HEAD_DIM)
    v = v.reshape(b, t, N_KV_HEADS, HEAD_DIM)
    if past_k is None:
        attn = window_attention_prompt(q, k, v, sinks)
        new_k, new_v = k[:, -WINDOW:], v[:, -WINDOW:]
        conv_buf = jnp.zeros((b, CONV_WIDTH - 1, CONV_DIM), u.dtype)
        h0 = jnp.zeros((b, SSM_HEADS, SSM_HEAD_DIM, SSM_STATE), jnp.float32)
        ssd_chunk = CHUNK
    else:
        attn = window_attention_sample(q, k, v, past_k, past_v, sinks)
        new_k, new_v = k, v
        ssd_chunk = t
    xbc, new_conv = causal_conv(xbc, conv_buf, conv_w, conv_b)
    xs, bm, cm = jnp.split(xbc, [D_SSM, D_SSM + SSM_GROUPS * SSM_STATE], axis=-1)
    xs = xs.reshape(b, t, SSM_HEADS, SSM_HEAD_DIM)
    bm = bm.reshape(b, t, SSM_GROUPS, SSM_STATE)
    cm = cm.reshape(b, t, SSM_GROUPS, SSM_STATE)
    dt = jax.nn.softplus(dt_raw.astype(jnp.float32) + dt_bias.astype(jnp.float32))
    y, h_last = ssd_scan(xs, dt, a_log, bm, cm, h0, ssd_chunk)
    y = y + xs.astype(jnp.float32) * d_skip.astype(jnp.float32)[:, None]
    y = gated_group_rmsnorm(y.reshape(b, t, D_SSM), z, ssm_norm_w).astype(u.dtype)
    out = jnp.concatenate([attn.astype(u.dtype), y], axis=-1) @ w_out
    return out, new_k, new_v, new_conv, h_last.astype(u.dtype)


def swiglu(u, w_gate, w_up, w_down):
    return (jax.nn.silu(u @ w_gate) * (u @ w_up)) @ w_down


def setup_inputs(seed: int = 0) -> dict:
    key = jax.random.key(seed)
    ks = jax.random.split(key, 24)
    f32 = jnp.float32
    nrm = lambda k, shape, s: jax.random.normal(k, shape, f32) * s
    dt0 = jnp.exp(jax.random.uniform(ks[10], (DEPTH, SSM_HEADS), f32, np.log(1e-3), np.log(1e-1)))
    return {
        'x_prompt': nrm(ks[0], (BATCH, SEQ, D_MODEL), 1.0),
        'x_sample': nrm(ks[1], (DEC_BATCH, DEC_SEQ, D_MODEL), 1.0),
        'cache_k': nrm(ks[2], (DEPTH, DEC_BATCH, WINDOW, N_KV_HEADS, HEAD_DIM), 1.0),
        'cache_v': nrm(ks[3], (DEPTH, DEC_BATCH, WINDOW, N_KV_HEADS, HEAD_DIM), 1.0),
        'state_conv': nrm(ks[4], (DEPTH, DEC_BATCH, CONV_WIDTH - 1, CONV_DIM), 1.0),
        'state_ssm': nrm(ks[5], (DEPTH, DEC_BATCH, SSM_HEADS, SSM_HEAD_DIM, SSM_STATE), 0.5),
        'ln1_g': 1.0 + nrm(ks[6], (DEPTH, D_MODEL), 0.01),
        'w_in': nrm(ks[7], (DEPTH, D_MODEL, D_IN), D_MODEL ** -0.5),
        'conv_w': nrm(ks[8], (DEPTH, CONV_WIDTH, CONV_DIM), CONV_WIDTH ** -0.5),
        'conv_b': nrm(ks[9], (DEPTH, CONV_DIM), 0.01),
        'dt_bias': dt0 + jnp.log(-jnp.expm1(-dt0)),
        'a_log': jnp.log(jax.random.uniform(ks[11], (DEPTH, SSM_HEADS), f32, 1.0, 16.0)),
        'd_skip': 1.0 + nrm(ks[12], (DEPTH, SSM_HEADS), 0.01),
        'ssm_norm_w': 1.0 + nrm(ks[13], (DEPTH, D_SSM), 0.01),
        'sinks': nrm(ks[14], (DEPTH, N_HEADS), 0.5),
        'w_out': nrm(ks[15], (DEPTH, D_MIX, D_MODEL), D_MIX ** -0.5),
        'ln2_g': 1.0 + nrm(ks[16], (DEPTH, D_MODEL), 0.01),
        'w_gate': nrm(ks[17], (DEPTH, D_MODEL, D_FF), D_MODEL ** -0.5),
        'w_up': nrm(ks[18], (DEPTH, D_MODEL, D_FF), D_MODEL ** -0.5),
        'w_down': nrm(ks[19], (DEPTH, D_FF, D_MODEL), D_FF ** -0.5),
        'final_g': 1.0 + nrm(ks[20], (D_MODEL,), 0.01),
    }


def reference(x_prompt, x_sample, cache_k, cache_v, state_conv, state_ssm, ln1_g, w_in, conv_w, conv_b,
              dt_bias, a_log, d_skip, ssm_norm_w, sinks, w_out, ln2_g, w_gate, w_up, w_down, final_g):
    hp, hs = x_prompt, x_sample
    kp_l, vp_l, cp_l, sp_l, ks_l, vs_l, cs_l, ss_l = [], [], [], [], [], [], [], []
    for l in range(DEPTH):
        mixer = functools.partial(hybrid_mixer, w_in=w_in[l], conv_w=conv_w[l], conv_b=conv_b[l],
                                  dt_bias=dt_bias[l], a_log=a_log[l], d_skip=d_skip[l],
                                  ssm_norm_w=ssm_norm_w[l], sinks=sinks[l], w_out=w_out[l])
        mp, kp, vp, cp, sp = mixer(rmsnorm(hp, ln1_g[l]), None, None, None, None)
        ms, kn, vn, cn, sn = mixer(rmsnorm(hs, ln1_g[l]), cache_k[l], cache_v[l], state_conv[l], state_ssm[l])
        hp = hp + mp
        hs = hs + ms
        hp = hp + swiglu(rmsnorm(hp, ln2_g[l]), w_gate[l], w_up[l], w_down[l])
        hs = hs + swiglu(rmsnorm(hs, ln2_g[l]), w_gate[l], w_up[l], w_down[l])
        kp_l.append(kp); vp_l.append(vp); cp_l.append(cp); sp_l.append(sp)
        ks_l.append(kn); vs_l.append(vn); cs_l.append(cn); ss_l.append(sn)
    y_prompt = rmsnorm(hp, final_g)
    y_sample = rmsnorm(hs, final_g)
    return (y_prompt, y_sample, jnp.stack(kp_l), jnp.stack(vp_l), jnp.stack(cp_l), jnp.stack(sp_l),
            jnp.stack(ks_l), jnp.stack(vs_l), jnp.stack(cs_l), jnp.stack(ss_l))
```

```cpp
#include <hip/hip_runtime.h>
#include <hip/hip_cooperative_groups.h>
#include <cstdio>
#include <cstdint>
namespace cg = cooperative_groups;
namespace pg8 {
#define PG8_LAS __attribute__((address_space(3)))
typedef unsigned short bf16_t;
typedef short bf16x8 __attribute__((ext_vector_type(8)));
typedef float f32x4 __attribute__((ext_vector_type(4)));
typedef unsigned u32x4 __attribute__((ext_vector_type(4)));
constexpr int BM = 256, BK = 64, HALF = 128, HTB = HALF * BK * 2  , STAGE_BYTES = 8 * HTB, NXCD = 8, WGM = 8;

__host__ __device__ __forceinline__ int lds_byte(int r, int c) { const int st = (r >> 4) * 2 + (c >> 5), rr = r & 15, cc = c & 31, ob = rr * 64 + cc * 2; return st * 1024 + (ob ^ (((ob >> 9) & 1) << 5)); }
__host__ __device__ __forceinline__ void stage_rc(int b, int& R, int& C) { const int st = b / 1024, sb = b % 1024, swz = sb ^ (((sb >> 9) & 1) << 5); R = (st >> 1) * 16 + swz / 64; C = (st & 1) * 32 + (swz % 64) / 2; }
__host__ __device__ __forceinline__ int perm32(int rho) { const int n = rho >> 4, i = rho & 15; return 8 * (i >> 2) + 4 * n + (i & 3); }

struct Unit { int pm, pn; };
struct Gemm { const bf16_t* A; const bf16_t* Bt; int M, N, K, lda; };

struct StaticOrder {
    int nM, nN, nwg, G, c;
    __host__ __device__ void init(int M, int N, int G_, int c_) { nM = M / BM; nN = N / BM; nwg = nM * nN; G = G_; c = c_; }
    __host__ __device__ bool next(int i, Unit& u) const {
        const long L = (long)i * G + c; if (L >= nwg) return false;
        int wgid = (int)L; { const int q = nwg / NXCD, r = nwg % NXCD, xcd = wgid % NXCD, off = wgid / NXCD; wgid = (xcd < r ? xcd * (q + 1) : r * (q + 1) + (xcd - r) * q) + off; }
        const int nig = WGM * nN, gid = wgid / nig, fm = gid * WGM, gsz = (nM - fm) < WGM ? (nM - fm) : WGM;
        u.pm = fm + ((wgid % nig) % gsz); u.pn = (wgid % nig) / gsz; return true;
    }
    __device__ __forceinline__ void a_ready(const Unit&) const {}
    __device__ __forceinline__ void done(const Unit&) const {}
};

__device__ __forceinline__ unsigned cvt_pk_bf16(float lo, float hi) { unsigned r; asm volatile("v_cvt_pk_bf16_f32 %0, %1, %2" : "=v"(r) : "v"(lo), "v"(hi)); return r; }
typedef float f32x2 __attribute__((ext_vector_type(2)));
__device__ __forceinline__ f32x2 gelu_pk(f32x2 v) {
    const f32x2 av = __builtin_elementwise_abs(v), d = av * 0.2316418882f + 1.0f;
    f32x2 t; t.x = __builtin_amdgcn_rcpf(d.x); t.y = __builtin_amdgcn_rcpf(d.y);
    f32x2 q = t * 0.5307027145f + (-0.7265760135f); q = q * t + 0.7107068705f; q = q * t + (-0.142248368f); q = q * t + 0.127414796f; q = q * t;
    const f32x2 s = (v * v) * (-0.72134752044f);
    f32x2 e; e.x = __builtin_amdgcn_exp2f(s.x); e.y = __builtin_amdgcn_exp2f(s.y);
    const f32x2 m = v * (q * e), r = v - m;
    f32x2 o; o.x = v.x < 0.f ? m.x : r.x; o.y = v.y < 0.f ? m.y : r.y; return o;
}

template <int ACT  > struct EpiBf16 {
    static constexpr bool PERM = true, AFTER_DRAIN = false; static_assert(ACT == 0 || ACT == 1, "EpiBf16: ACT is 0 (none) or 1 (gelu_pk)");
    bf16_t* O; int ldc; const float* bias; int split_cols; size_t split_stride; float scale0;
    __device__ __forceinline__ void operator()(const f32x4 (&acc)[2][2][4][2], const Unit& u, int wr, int wc, int fr, int fq) const {
        const int row0 = u.pm * BM + wr * 64 + fr; int colt = u.pn * BM; bf16_t* base = O;
        float sc = 1.f; if (split_cols) { const int t = colt / split_cols; base += (size_t)t * split_stride; colt -= t * split_cols; if (t == 0) sc = scale0; }
        const int col0 = colt + wc * 64 + 8 * fq, bcol0 = u.pn * BM + wc * 64 + 8 * fq;
        f32x4 bv[2][2];
#pragma unroll
        for (int bj = 0; bj < 2; ++bj)
#pragma unroll
            for (int n = 0; n < 2; ++n) bv[bj][n] = bias ? *(const f32x4*)(bias + bcol0 + bj * 32 + 4 * n) : (f32x4){0.f, 0.f, 0.f, 0.f};
#pragma unroll
        for (int ai = 0; ai < 2; ++ai)
#pragma unroll
            for (int m = 0; m < 4; ++m) { bf16_t* rowp = base + (size_t)(row0 + ai * HALF + m * 16) * ldc + col0;
#pragma unroll
                for (int bj = 0; bj < 2; ++bj) { f32x4 v0 = acc[ai][bj][m][0] + bv[bj][0], v1 = acc[ai][bj][m][1] + bv[bj][1];
                    if (ACT == 1) { f32x2 a = gelu_pk((f32x2){v0[0], v0[1]}), b = gelu_pk((f32x2){v0[2], v0[3]}), c = gelu_pk((f32x2){v1[0], v1[1]}), d = gelu_pk((f32x2){v1[2], v1[3]});
                        v0 = (f32x4){a.x, a.y, b.x, b.y}; v1 = (f32x4){c.x, c.y, d.x, d.y}; }
                    v0 = v0 * sc; v1 = v1 * sc; u32x4 w; w.x = cvt_pk_bf16(v0[0], v0[1]); w.y = cvt_pk_bf16(v0[2], v0[3]); w.z = cvt_pk_bf16(v1[0], v1[1]); w.w = cvt_pk_bf16(v1[2], v1[3]);
                    __builtin_nontemporal_store(w, (u32x4*)(rowp + bj * 32)); } }
    }
};

template <class Epi, class Sched, bool ALIGN_EPI = false, bool SP2 = false>
__device__ __forceinline__ void gemm_phase(PG8_LAS unsigned char* lds, const Gemm g, const Sched& S, const Epi& E) {
    const int tid = threadIdx.x, wid = __builtin_amdgcn_readfirstlane(tid >> 6), lane = tid & 63, wr = wid >> 2, wc = wid & 3, fr = lane & 15, fq = lane >> 4;
    const int K = g.K, nt = K / BK;
    unsigned voffA[2], voffB[2];
#pragma unroll
    for (int i = 0; i < 2; ++i) { int R, C; stage_rc(tid * 16 + i * 8192, R, C); const int Rb = Epi::PERM ? (64 * (R >> 5) + perm32(R & 31)) : R;
        voffA[i] = (unsigned)(R * g.lda + C) * 2u; voffB[i] = (unsigned)(Rb * K + C) * 2u; }
    const size_t kstep = (size_t)(BK * 2);
    const size_t hstepB = (size_t)(Epi::PERM ? 32 : HALF) * K * 2, hstepA = (size_t)HALF * g.lda * 2;
    const size_t tstepA = 2 * hstepA, tstepB = (size_t)BM * K * 2;
    const unsigned ldsw = (unsigned)wid * 1024u;
    const int aoff = lds_byte(wr * 64 + fr, fq * 8), boff = lds_byte(wc * 32 + fr, fq * 8);
#define PG8_SA(b, h) (((b) * 2 + (h)) * HTB)
#define PG8_SB(b, h) ((4 + (b) * 2 + (h)) * HTB)
#define PG8_STAGE(bufoff, gbase, voff) do { _Pragma("unroll") for (int _i = 0; _i < 2; ++_i) \
        __builtin_amdgcn_global_load_lds((const unsigned*)((const char*)(gbase) + (voff)[_i]), (PG8_LAS unsigned*)(lds + (bufoff) + ldsw + _i * 8192), 16, 0, 0); } while (0)
#define PG8_LDA(dst, b, h) do { _Pragma("unroll") for (int m = 0; m < 4; ++m) _Pragma("unroll") for (int k = 0; k < 2; ++k) dst[m][k] = *(const PG8_LAS bf16x8*)(lds + PG8_SA(b, h) + aoff + m * 2048 + k * 1024); } while (0)
#define PG8_LDB(dst, b, h) do { _Pragma("unroll") for (int n = 0; n < 2; ++n) _Pragma("unroll") for (int k = 0; k < 2; ++k) dst[n][k] = *(const PG8_LAS bf16x8*)(lds + PG8_SB(b, h) + boff + n * 2048 + k * 1024); } while (0)
#define PG8_MMA(ai, bj, At, Bt) do { __builtin_amdgcn_s_setprio(1); _Pragma("unroll") for (int m = 0; m < 4; ++m) _Pragma("unroll") for (int n = 0; n < 2; ++n) _Pragma("unroll") for (int k = 0; k < 2; ++k) \
        acc[ai][bj][m][n] = __builtin_amdgcn_mfma_f32_16x16x32_bf16(Bt[n][k], At[m][k], acc[ai][bj][m][n], 0, 0, 0); __builtin_amdgcn_s_setprio(0); } while (0)
#define PG8_WAIT_V(n) asm volatile("s_waitcnt vmcnt(" #n ")" ::: "memory")
#define PG8_WAIT_L(n) asm volatile("s_waitcnt lgkmcnt(" #n ")" ::: "memory")
#define PG8_BAR __builtin_amdgcn_s_barrier()
#define PG8_SCHED __builtin_amdgcn_sched_barrier(0)
    Unit cur, nxt; int ui = 0;
    if (!S.next(0, cur)) return;
    f32x4 acc[2][2][4][2];
#pragma unroll
    for (int a = 0; a < 2; ++a)
#pragma unroll
        for (int b = 0; b < 2; ++b)
#pragma unroll
            for (int m = 0; m < 4; ++m)
#pragma unroll
                for (int n = 0; n < 2; ++n) acc[a][b][m][n] = (f32x4){0.f, 0.f, 0.f, 0.f};
    bf16x8 At[4][2], B0[2][2], B1[2][2];
    const char* cA = (const char*)g.A + (size_t)cur.pm * tstepA; const char* cB = (const char*)g.Bt + (size_t)cur.pn * tstepB;
    S.a_ready(cur);
    if constexpr (SP2) {
        PG8_STAGE(PG8_SB(0, 0), cB, voffB); PG8_STAGE(PG8_SB(0, 1), cB + hstepB, voffB); PG8_STAGE(PG8_SA(0, 0), cA, voffA); PG8_STAGE(PG8_SA(0, 1), cA + hstepA, voffA);
        if (wr == 1) PG8_BAR;
        PG8_WAIT_V(2); PG8_BAR;
        PG8_STAGE(PG8_SB(1, 0), cB + kstep, voffB); PG8_STAGE(PG8_SA(1, 0), cA + kstep, voffA); PG8_STAGE(PG8_SB(1, 1), cB + hstepB + kstep, voffB);
        PG8_WAIT_V(6); PG8_BAR;
    } else {
        PG8_STAGE(PG8_SB(0, 0), cB, voffB); PG8_STAGE(PG8_SA(0, 0), cA, voffA); PG8_STAGE(PG8_SB(0, 1), cB + hstepB, voffB); PG8_STAGE(PG8_SA(0, 1), cA + hstepA, voffA);
        if (wr == 1) PG8_BAR;
        PG8_WAIT_V(4); PG8_BAR;
        PG8_STAGE(PG8_SB(1, 0), cB + kstep, voffB); PG8_STAGE(PG8_SA(1, 0), cA + kstep, voffA); PG8_STAGE(PG8_SB(1, 1), cB + hstepB + kstep, voffB);
        PG8_WAIT_V(6); PG8_BAR;
    }
    for (;;) {
        const bool has_next = S.next(ui + 1, nxt);
        const char* nA = has_next ? (const char*)g.A + (size_t)nxt.pm * tstepA : cA; const char* nB = has_next ? (const char*)g.Bt + (size_t)nxt.pn * tstepB : cB;
        for (int t = 0; t < nt; t += 2) {
            const bool last = (t == nt - 2);
            const char* a1 = cA + (size_t)(t + 1) * kstep;
            const char* a2 = last ? nA : cA + (size_t)(t + 2) * kstep; const char* b2 = last ? nB : cB + (size_t)(t + 2) * kstep;
            const char* a3 = a2 + kstep; const char* b3 = b2 + kstep;
            if (last && has_next) S.a_ready(nxt);
            if constexpr (SP2) {
            PG8_LDB(B0, 0, 0); PG8_LDB(B1, 0, 1); PG8_SCHED; PG8_LDA(At, 0, 0); PG8_STAGE(PG8_SA(1, 1), a1 + hstepA, voffA);
            PG8_WAIT_V(8); PG8_WAIT_L(0); PG8_BAR; PG8_MMA(0, 0, At, B0); PG8_MMA(0, 1, At, B1); PG8_BAR; PG8_SCHED;
            PG8_LDA(At, 0, 1); PG8_STAGE(PG8_SB(0, 0), b2, voffB); PG8_STAGE(PG8_SB(0, 1), b2 + hstepB, voffB); PG8_STAGE(PG8_SA(0, 0), a2, voffA);
            PG8_WAIT_V(8); PG8_WAIT_L(0); PG8_BAR; PG8_MMA(1, 0, At, B0); PG8_MMA(1, 1, At, B1); PG8_BAR; PG8_SCHED;
            PG8_LDB(B0, 1, 0); PG8_LDB(B1, 1, 1); PG8_SCHED; PG8_LDA(At, 1, 0); PG8_STAGE(PG8_SA(0, 1), a2 + hstepA, voffA);
            PG8_WAIT_V(8); PG8_WAIT_L(0); PG8_BAR; PG8_MMA(0, 0, At, B0); PG8_MMA(0, 1, At, B1); PG8_BAR; PG8_SCHED;
            PG8_LDA(At, 1, 1); PG8_STAGE(PG8_SB(1, 0), b3, voffB); PG8_STAGE(PG8_SB(1, 1), b3 + hstepB, voffB); PG8_STAGE(PG8_SA(1, 0), a3, voffA);
            PG8_WAIT_V(8); PG8_WAIT_L(0); PG8_BAR; PG8_MMA(1, 0, At, B0); PG8_MMA(1, 1, At, B1); PG8_BAR; PG8_SCHED;
            } else {
            PG8_LDB(B0, 0, 0); PG8_SCHED; PG8_LDA(At, 0, 0); PG8_STAGE(PG8_SA(1, 1), a1 + hstepA, voffA);
            PG8_WAIT_L(8); PG8_BAR; PG8_WAIT_L(0); PG8_MMA(0, 0, At, B0); PG8_BAR; PG8_SCHED;
            PG8_LDB(B1, 0, 1); PG8_STAGE(PG8_SB(0, 0), b2, voffB);
            PG8_BAR; PG8_WAIT_L(0); PG8_MMA(0, 1, At, B1); PG8_BAR;
            PG8_LDA(At, 0, 1); PG8_STAGE(PG8_SA(0, 0), a2, voffA);
            PG8_BAR; PG8_WAIT_L(0); PG8_MMA(1, 0, At, B0); PG8_BAR; PG8_SCHED;
            PG8_STAGE(PG8_SB(0, 1), b2 + hstepB, voffB);
            PG8_WAIT_V(6); PG8_BAR; PG8_MMA(1, 1, At, B1); PG8_BAR;
            PG8_LDB(B0, 1, 0); PG8_SCHED; PG8_LDA(At, 1, 0); PG8_STAGE(PG8_SA(0, 1), a2 + hstepA, voffA);
            PG8_WAIT_L(8); PG8_BAR; PG8_WAIT_L(0); PG8_MMA(0, 0, At, B0); PG8_BAR; PG8_SCHED;
            PG8_LDB(B1, 1, 1); PG8_STAGE(PG8_SB(1, 0), b3, voffB);
            PG8_BAR; PG8_WAIT_L(0); PG8_MMA(0, 1, At, B1); PG8_BAR;
            PG8_LDA(At, 1, 1); PG8_STAGE(PG8_SA(1, 0), a3, voffA);
            PG8_BAR; PG8_WAIT_L(0); PG8_MMA(1, 0, At, B0); PG8_BAR; PG8_SCHED;
            PG8_STAGE(PG8_SB(1, 1), b3 + hstepB, voffB);
            PG8_WAIT_V(6); PG8_BAR; PG8_MMA(1, 1, At, B1); PG8_BAR;
            }
        }
        if constexpr (ALIGN_EPI) { if (wr == 0) PG8_BAR; }
        if constexpr (!Epi::AFTER_DRAIN) { E(acc, cur, wr, wc, fr, fq); S.done(cur); }
        if (!has_next) break;
#pragma unroll
        for (int a = 0; a < 2; ++a)
#pragma unroll
            for (int b = 0; b < 2; ++b)
#pragma unroll
                for (int m = 0; m < 4; ++m)
#pragma unroll
                    for (int n = 0; n < 2; ++n) acc[a][b][m][n] = (f32x4){0.f, 0.f, 0.f, 0.f};
        cur = nxt; cA = nA; cB = nB; ++ui;
        if constexpr (ALIGN_EPI) { if (wr == 1) PG8_BAR; }
    }
    PG8_WAIT_V(0);
    if constexpr (!ALIGN_EPI) { if (wr == 0) PG8_BAR; }
    PG8_BAR;
    if constexpr (Epi::AFTER_DRAIN) { E.fused(acc, cur, wr, wc, fr, fq, lds, wid, lane); S.done(cur); }
#undef PG8_SA
#undef PG8_SB
#undef PG8_STAGE
#undef PG8_LDA
#undef PG8_LDB
#undef PG8_MMA
#undef PG8_WAIT_V
#undef PG8_WAIT_L
#undef PG8_BAR
#undef PG8_SCHED
}
}

#ifndef MK_MULTI
#define MK_MULTI 0
#endif
#define LAS __attribute__((address_space(3)))
typedef unsigned short bf16;
typedef unsigned v4u __attribute__((ext_vector_type(4)));
typedef unsigned v2u __attribute__((ext_vector_type(2)));
typedef float f32x4 __attribute__((ext_vector_type(4)));
typedef float f32x16 __attribute__((ext_vector_type(16)));
typedef short bf16x8 __attribute__((ext_vector_type(8)));
typedef short s16x4 __attribute__((ext_vector_type(4)));

constexpr int NWAVES = 8, NTHR = 512;
constexpr int DM = 1024, NPR = 32768, NSR = 256, MROWS = NPR + NSR;
constexpr int NQ = 4608;
constexpr int Q0 = 0, Z0 = 1024, K0 = 2048, V0 = 2304, X0 = 2560;
constexpr int DIN = 4624, DFF = 2816;
constexpr float EPS = 1e-6f, SCALE = 0.125f;
constexpr int NPHASE = 7;

constexpr size_t MiB = 1u << 20;
constexpr size_t WS_CTL = 0, WS_WIN = 1 * MiB, WS_WDT = 10 * MiB, WS_WOUT = 11 * MiB, WS_WGU = 15 * MiB, WS_WDN = 26 * MiB;
constexpr size_t WS_SSQ1 = 32 * MiB, WS_SSQ2 = 32 * MiB + 256 * 1024, WS_GSS = 32 * MiB + 512 * 1024, WS_DT = 33 * MiB + 512 * 1024, WS_CS = 36 * MiB, WS_WD = 39 * MiB, WS_XN = 42 * MiB, WS_QKV = 107 * MiB, WS_XC1 = 398 * MiB, WS_FFS = 464 * MiB, WS_END = 466 * MiB;

constexpr int OUT_YP = 0, OUT_YS = 33554432, OUT_KP = 33816576, OUT_VP = 34078720, OUT_CP = 34340864, OUT_SP = 34390016,
              OUT_KS = 35438592, OUT_VS = 35504128, OUT_CS = 35569664, OUT_SS = 35667968;

constexpr int LDS_BYTES = 147456, LDS_CTL = 131072 + 8192;

struct Args { const float* in[21]; float* out; unsigned char* ws; int ph_lo, ph_hi; };

typedef __bf16 bf2_t __attribute__((ext_vector_type(2)));
typedef float f2_t __attribute__((ext_vector_type(2)));
__device__ __forceinline__ unsigned pk2(float lo, float hi) { const f2_t v = {lo, hi}; return __builtin_bit_cast(unsigned, __builtin_convertvector(v, bf2_t)); }
__device__ __forceinline__ unsigned f2bf(float f) { return pk2(f, 0.f) & 0xffffu; }
__device__ __forceinline__ float bflo(unsigned u) { return __uint_as_float(u << 16); }
__device__ __forceinline__ float bfhi(unsigned u) { return __uint_as_float(u & 0xffff0000u); }
__device__ __forceinline__ float silu_f(float x) { return x * __builtin_amdgcn_rcpf(1.f + __expf(-x)); }
__device__ __forceinline__ float wave_sum(float v) {
#pragma unroll
    for (int o = 1; o < 64; o <<= 1) v += __shfl_xor(v, o);
    return v;
}
__device__ __forceinline__ float wave_max(float v) {
#pragma unroll
    for (int o = 1; o < 64; o <<= 1) v = fmaxf(v, __shfl_xor(v, o));
    return v;
}
__device__ __forceinline__ float sum8_first(float v) {
    v += __builtin_bit_cast(float, __builtin_amdgcn_update_dpp(0, __builtin_bit_cast(int, v), 0xB1, 0xF, 0xF, true));
    v += __builtin_bit_cast(float, __builtin_amdgcn_update_dpp(0, __builtin_bit_cast(int, v), 0x4E, 0xF, 0xF, true));
    v += __builtin_bit_cast(float, __builtin_amdgcn_update_dpp(0, __builtin_bit_cast(int, v), 0x104, 0xF, 0xF, true));
    return v;
}
#define LDS_WAIT() asm volatile("s_waitcnt lgkmcnt(0)" ::: "memory")
#define MFMA32(a, b, c) __builtin_amdgcn_mfma_f32_32x32x16_bf16((a), (b), (c), 0, 0, 0)

namespace pg8 {
struct EpiRes1 {
    static constexpr bool PERM = true, AFTER_DRAIN = false;
    const float* xp; const float* xs; float* out; bf16_t* hb; float* ssq;
    __device__ __forceinline__ void operator()(const f32x4 (&acc)[2][2][4][2], const Unit& u, int wr, int wc, int fr, int fq) const {
        const float* base = u.pm < 128 ? xp + (size_t)u.pm * 256 * 1024 : xs;
        bf16_t* hbo = hb + (size_t)u.pm * 256 * 1024;
        const int col0 = u.pn * BM + wc * 64 + 8 * fq;
#pragma unroll
        for (int ai = 0; ai < 2; ++ai)
#pragma unroll
            for (int m = 0; m < 4; ++m) { const int r = ai * HALF + wr * 64 + m * 16 + fr; const unsigned off = (unsigned)r * 1024u + (unsigned)col0; float ss = 0.f;
#pragma unroll
                for (int bj = 0; bj < 2; ++bj) {
                    const f32x4 v0 = __builtin_nontemporal_load((const f32x4*)(base + off + bj * 32)) + acc[ai][bj][m][0];
                    const f32x4 v1 = __builtin_nontemporal_load((const f32x4*)(base + off + bj * 32 + 4)) + acc[ai][bj][m][1];
                    ss += (v0[0] * v0[0] + v0[1] * v0[1]) + (v0[2] * v0[2] + v0[3] * v0[3]) + (v1[0] * v1[0] + v1[1] * v1[1]) + (v1[2] * v1[2] + v1[3] * v1[3]);
                    u32x4 w; w.x = cvt_pk_bf16(v0[0], v0[1]); w.y = cvt_pk_bf16(v0[2], v0[3]); w.z = cvt_pk_bf16(v1[0], v1[1]); w.w = cvt_pk_bf16(v1[2], v1[3]);
                    *(u32x4*)(hbo + off + bj * 32) = w; }
                ss += __shfl_xor(ss, 16); ss += __shfl_xor(ss, 32);
                if (fq == 0) atomicAdd(ssq + u.pm * 256 + r, ss); }
    }
};
struct EpiSwiGLU {
    static constexpr bool PERM = true, AFTER_DRAIN = false;
    const float* ssq; bf16_t* O;
    __device__ __forceinline__ void operator()(const f32x4 (&acc)[2][2][4][2], const Unit& u, int wr, int wc, int fr, int fq) const {
        const int row0 = u.pm * BM + wr * 64 + fr, col0 = u.pn * HALF + wc * 32 + 8 * fq;
#pragma unroll
        for (int ai = 0; ai < 2; ++ai)
#pragma unroll
            for (int m = 0; m < 4; ++m) { const int row = row0 + ai * HALF + m * 16; const float rstd = __builtin_amdgcn_rsqf(ssq[row] * (1.0f / 1024.0f) + 1e-6f);
                float r[8];
#pragma unroll
                for (int n = 0; n < 2; ++n)
#pragma unroll
                    for (int e = 0; e < 4; ++e) { const float gv = acc[ai][0][m][n][e] * rstd, uv = acc[ai][1][m][n][e] * rstd; r[4 * n + e] = gv * __builtin_amdgcn_rcpf(1.f + __expf(-gv)) * uv; }
                u32x4 w; w.x = cvt_pk_bf16(r[0], r[1]); w.y = cvt_pk_bf16(r[2], r[3]); w.z = cvt_pk_bf16(r[4], r[5]); w.w = cvt_pk_bf16(r[6], r[7]);
                __builtin_nontemporal_store(w, (u32x4*)(O + (size_t)row * 2816 + col0)); }
    }
};
struct EpiRes2 {
    static constexpr bool PERM = false, AFTER_DRAIN = false;
    float* out;
    __device__ __forceinline__ void operator()(const f32x4 (&acc)[2][2][4][2], const Unit& u, int wr, int wc, int fr, int fq) const {
        float* o = out + (size_t)u.pm * 256 * 1024; const int col0 = u.pn * BM + wc * 32 + 4 * fq;
#pragma unroll
        for (int ai = 0; ai < 2; ++ai)
#pragma unroll
            for (int m = 0; m < 4; ++m) { const int r = ai * HALF + wr * 64 + m * 16 + fr; const size_t off = (size_t)r * 1024 + col0;
#pragma unroll
                for (int bj = 0; bj < 2; ++bj)
#pragma unroll
                    for (int n = 0; n < 2; ++n) { f32x4* p = (f32x4*)(o + off + bj * HALF + n * 16); *p = *p + acc[ai][bj][m][n]; } }
    }
};
struct EpiFinal {
    static constexpr bool PERM = true, AFTER_DRAIN = false;
    float* out; const bf16_t* hb; const float* gfin; float* ssq2; unsigned* cnt;
    __device__ __forceinline__ void operator()(const f32x4 (&acc)[2][2][4][2], const Unit& u, int wr, int wc, int fr, int fq) const {
        float* o = out + (size_t)u.pm * 256 * 1024; const bf16_t* hbo = hb + (size_t)u.pm * 256 * 1024; const int col0 = u.pn * BM + wc * 64 + 8 * fq;
        u32x4 v[2][4][2];
#pragma unroll
        for (int ai = 0; ai < 2; ++ai)
#pragma unroll
            for (int m = 0; m < 4; ++m) { const int r = ai * HALF + wr * 64 + m * 16 + fr; const unsigned off = (unsigned)r * 1024u + (unsigned)col0; float ss = 0.f;
#pragma unroll
                for (int bj = 0; bj < 2; ++bj) { const u32x4 hw = *(const u32x4*)(hbo + off + bj * 32); f32x4 x0 = acc[ai][bj][m][0], x1 = acc[ai][bj][m][1];
                    x0[0] += __uint_as_float(hw.x << 16); x0[1] += __uint_as_float(hw.x & 0xffff0000u); x0[2] += __uint_as_float(hw.y << 16); x0[3] += __uint_as_float(hw.y & 0xffff0000u);
                    x1[0] += __uint_as_float(hw.z << 16); x1[1] += __uint_as_float(hw.z & 0xffff0000u); x1[2] += __uint_as_float(hw.w << 16); x1[3] += __uint_as_float(hw.w & 0xffff0000u);
                    ss += (x0[0] * x0[0] + x0[1] * x0[1]) + (x0[2] * x0[2] + x0[3] * x0[3]) + (x1[0] * x1[0] + x1[1] * x1[1]) + (x1[2] * x1[2] + x1[3] * x1[3]);
                    u32x4 w; w.x = cvt_pk_bf16(x0[0], x0[1]); w.y = cvt_pk_bf16(x0[2], x0[3]); w.z = cvt_pk_bf16(x1[0], x1[1]); w.w = cvt_pk_bf16(x1[2], x1[3]); v[ai][m][bj] = w; }
                ss += __shfl_xor(ss, 16); ss += __shfl_xor(ss, 32);
                if (fq == 0) atomicAdd(ssq2 + u.pm * 256 + r, ss); }
        asm volatile("s_waitcnt vmcnt(0)" ::: "memory");
        unsigned* c = cnt + 16 * u.pm;
        if ((threadIdx.x & 63) == 0) __hip_atomic_fetch_add(c, 1u, __ATOMIC_RELAXED, __HIP_MEMORY_SCOPE_AGENT);
        { unsigned sp = 0; for (;;) { const unsigned cv = (unsigned)__builtin_amdgcn_readfirstlane((int)__hip_atomic_load(c, __ATOMIC_RELAXED, __HIP_MEMORY_SCOPE_AGENT)); if (cv >= 32u) break; __builtin_amdgcn_s_sleep(2); if (++sp > (1u << 20)) break; } }
        asm volatile("" ::: "memory");
        f32x4 g[2][2];
#pragma unroll
        for (int bj = 0; bj < 2; ++bj)
#pragma unroll
            for (int n = 0; n < 2; ++n) g[bj][n] = *(const f32x4*)(gfin + col0 + bj * 32 + 4 * n);
#pragma unroll
        for (int ai = 0; ai < 2; ++ai)
#pragma unroll
            for (int m = 0; m < 4; ++m) { const int r = ai * HALF + wr * 64 + m * 16 + fr; const unsigned off = (unsigned)r * 1024u + (unsigned)col0;
                const float rstd = 1.0f / sqrtf(__hip_atomic_load(ssq2 + u.pm * 256 + r, __ATOMIC_RELAXED, __HIP_MEMORY_SCOPE_AGENT) * (1.0f / 1024.0f) + 1e-6f);
#pragma unroll
                for (int bj = 0; bj < 2; ++bj) { const u32x4 w = v[ai][m][bj];
                    const f32x4 x0 = {__uint_as_float(w.x << 16), __uint_as_float(w.x & 0xffff0000u), __uint_as_float(w.y << 16), __uint_as_float(w.y & 0xffff0000u)};
                    const f32x4 x1 = {__uint_as_float(w.z << 16), __uint_as_float(w.z & 0xffff0000u), __uint_as_float(w.w << 16), __uint_as_float(w.w & 0xffff0000u)};
                    __builtin_nontemporal_store(x0 * rstd * g[bj][0], (f32x4*)(o + off + bj * 32));
                    __builtin_nontemporal_store(x1 * rstd * g[bj][1], (f32x4*)(o + off + bj * 32 + 4)); } }
    }
};
}

#define XB_TMO      128
#define XB_XCNT(j)  (256  + 64 * (j))
#define XB_XSUB(j)  (1280 + 64 * (j))
#define XB_XGEN(j)  (2304 + 64 * (j))
#define XB_TOP      3328
#define XB_TOPGEN   3392
#define XCD_BAR_WORDS 3456
#define XB_SPIN_CAP (1u << 18)

__device__ __forceinline__ unsigned xb_ld(unsigned* p)              { return __hip_atomic_load(p, __ATOMIC_RELAXED, __HIP_MEMORY_SCOPE_AGENT); }
__device__ __forceinline__ unsigned xb_add(unsigned* p, unsigned v) { return __hip_atomic_fetch_add(p, v, __ATOMIC_RELAXED, __HIP_MEMORY_SCOPE_AGENT); }
__device__ __forceinline__ unsigned xb_xcc_id() { return (unsigned)__builtin_amdgcn_s_getreg((3 << 11) | 20) & 0xFu; }
#define XB_SPIN(cond, bar) do { unsigned _sp = 0; while (cond) { __builtin_amdgcn_s_sleep(1); \
    if ((++_sp & 255u) == 0u) { if (xb_ld(&(bar)[XB_TMO])) break; if (_sp > XB_SPIN_CAP) { atomicAdd(&(bar)[XB_TMO], 1u); break; } } } } while (0)

struct XcdBarrier {
    unsigned* bar; unsigned x;
    volatile LAS unsigned* st;
};

__device__ __forceinline__ XcdBarrier xcd_barrier_post(unsigned* bar, volatile LAS unsigned* st) {
    XcdBarrier b; b.bar = bar; b.x = xb_xcc_id(); b.st = st;
    if (threadIdx.x == 0) (void)xb_add(&bar[XB_XCNT(b.x)], 1u);
    return b;
}
__device__ __forceinline__ void xcd_barrier_complete(unsigned* bar, unsigned x, unsigned& nloc, unsigned& nx) {
    const unsigned G = gridDim.x * gridDim.y * gridDim.z;
    unsigned sum, cnt, mine, sp = 0u;
    for (;;) {
        sum = 0u; cnt = 0u; mine = 0u;
#pragma unroll
        for (unsigned j = 0; j < 16; ++j) { const unsigned c = xb_ld(&bar[XB_XCNT(j)]); sum += c; cnt += (c > 0u) ? 1u : 0u; mine = (j == x) ? c : mine; }
        if (sum == G) break;
        __builtin_amdgcn_s_sleep(1);
        if ((++sp & 255u) == 0u) { if (xb_ld(&bar[XB_TMO])) break; if (sp > XB_SPIN_CAP) { atomicAdd(&bar[XB_TMO], 1u); break; } }
    }
    nloc = mine > 0u ? mine : 1u; nx = cnt > 0u ? cnt : 1u;
}

__device__ __forceinline__ void xcd_barrier(const XcdBarrier& b) {
    asm volatile("s_waitcnt vmcnt(0)" ::: "memory");
    __syncthreads();
    if (threadIdx.x == 0) {
        unsigned* bar = b.bar;
        __builtin_amdgcn_s_waitcnt(0);
        unsigned nloc = b.st[0], nx = b.st[1];
        if (nloc == 0u) { xcd_barrier_complete(bar, b.x, nloc, nx); b.st[0] = nloc; b.st[1] = nx; }
        const unsigned old = xb_add(&bar[XB_XSUB(b.x)], 1u);
        const unsigned gen = old / nloc;
        if (old + 1u == (gen + 1u) * nloc) {
            __builtin_amdgcn_fence(__ATOMIC_RELEASE, "agent");
            asm volatile("s_waitcnt vmcnt(0)" ::: "memory");
            const unsigned og = xb_add(&bar[XB_TOP], 1u);
            const unsigned tg = og / nx;
            if (og + 1u == (tg + 1u) * nx) xb_add(&bar[XB_TOPGEN], 1u);
            else XB_SPIN(xb_ld(&bar[XB_TOPGEN]) == tg, bar);
            __builtin_amdgcn_fence(__ATOMIC_ACQUIRE, "agent");
            xb_add(&bar[XB_XGEN(b.x)], 1u);
            asm volatile("s_waitcnt vmcnt(0)" ::: "memory");
        } else {
            XB_SPIN(xb_ld(&bar[XB_XGEN(b.x)]) == gen, bar);
            __builtin_amdgcn_fence(__ATOMIC_ACQUIRE, "agent");
            asm volatile("s_waitcnt vmcnt(0)" ::: "memory");
        }
    }
    __syncthreads();
}

struct Frame {
    LAS unsigned char* lds; int tid, lane, wave, G, bid;
    const float* in[21]; float* out; unsigned char* ws;
    bf16 *Win, *Wdt, *Wout, *Wgu, *Wdn, *XN, *QKV, *FF, *H1B; float *SSQ1, *SSQ2, *GSS, *DT, *CS, *WD; bf16 *XC0, *XC1, *FFS; unsigned* ctl;
};

__device__ __forceinline__ void transpose_item(const float* W, int ldw, int K, const float* kscale, bf16* WT, int out_row0, int n0, int k0, LAS float* scr, int lane) {
#pragma unroll 8
    for (int i = 0; i < 32; ++i) { const int kk = 2 * i + (lane >> 5); float w = W[(size_t)(k0 + kk) * ldw + n0 + (lane & 31)]; if (kscale) w *= kscale[k0 + kk]; scr[kk * 33 + (lane & 31)] = w; }
    LDS_WAIT(); asm volatile("" ::: "memory");
    const int c = lane & 7;
#pragma unroll
    for (int j = 0; j < 4; ++j) { const int n = (lane >> 3) + 8 * j; const LAS float* s = scr + (8 * c) * 33 + n;
        v4u o; o.x = pk2(s[0 * 33], s[1 * 33]); o.y = pk2(s[2 * 33], s[3 * 33]); o.z = pk2(s[4 * 33], s[5 * 33]); o.w = pk2(s[6 * 33], s[7 * 33]);
        *(v4u*)(WT + (size_t)(out_row0 + n) * K + k0 + 8 * c) = o; }
    LDS_WAIT(); asm volatile("" ::: "memory");
}
__device__ __forceinline__ void p0_prologue(Frame& F) {
    LAS float* scr = (LAS float*)(F.lds + F.wave * 16384);
    const int gw = F.bid * NWAVES + F.wave, NGW = F.G * NWAVES;
    const int gt = F.bid * NTHR + F.tid, NGT = F.G * NTHR;
    for (int i = gt; i < MROWS; i += NGT) { F.SSQ1[i] = 0.f; F.SSQ2[i] = 0.f; }
    for (int i = gt; i < MROWS * 4; i += NGT) F.GSS[i] = 0.f;
    for (int i = gt; i < 16 * 1024; i += NGT) { const int n = i >> 10, k = i & 1023; F.Wdt[i] = (bf16)f2bf(F.in[7][(size_t)k * DIN + 4608 + n]); }
    for (int it = gw; it < 16 * 144; it += NGW) {
        const int kb = it / 144, nb = it % 144, n0 = 32 * nb; const int orow = n0 < 1024 ? n0 : (n0 < 1536 ? n0 + 1024 : (n0 < 2560 ? n0 - 512 : n0));
        transpose_item(F.in[7], DIN, 1024, nullptr, F.Win, orow, n0, 64 * kb, scr, F.lane);
    }
    const f32x4* gp = (const f32x4*)F.in[6] + F.lane;
    f32x4 gv[4];
#pragma unroll
    for (int j = 0; j < 4; ++j) gv[j] = gp[64 * j];
    for (int m0 = gw; m0 < MROWS; m0 += 2 * NGW) {
        const int m1 = m0 + NGW; const bool has1 = m1 < MROWS;
        const float* xrow0 = m0 < NPR ? F.in[0] + (size_t)m0 * DM : F.in[1] + (size_t)(m0 - NPR) * DM;
        const float* xrow1 = !has1 ? xrow0 : (m1 < NPR ? F.in[0] + (size_t)m1 * DM : F.in[1] + (size_t)(m1 - NPR) * DM);
        const f32x4* xr0 = (const f32x4*)xrow0 + F.lane; const f32x4* xr1 = (const f32x4*)xrow1 + F.lane;
        f32x4 v0[4], v1[4]; float s0 = 0.f, s1 = 0.f;
#pragma unroll
        for (int j = 0; j < 4; ++j) { v0[j] = __builtin_nontemporal_load(xr0 + 64 * j); v1[j] = __builtin_nontemporal_load(xr1 + 64 * j); }
#pragma unroll
        for (int j = 0; j < 4; ++j) { s0 += (v0[j].x * v0[j].x + v0[j].y * v0[j].y) + (v0[j].z * v0[j].z + v0[j].w * v0[j].w); s1 += (v1[j].x * v1[j].x + v1[j].y * v1[j].y) + (v1[j].z * v1[j].z + v1[j].w * v1[j].w); }
        const float rstd0 = 1.0f / sqrtf(wave_sum(s0) * (1.f / DM) + EPS), rstd1 = 1.0f / sqrtf(wave_sum(s1) * (1.f / DM) + EPS);
        v2u* o0 = (v2u*)(F.XN + (size_t)m0 * DM) + F.lane;
#pragma unroll
        for (int j = 0; j < 4; ++j) { v2u w; w.x = pk2(v0[j].x * rstd0 * gv[j].x, v0[j].y * rstd0 * gv[j].y); w.y = pk2(v0[j].z * rstd0 * gv[j].z, v0[j].w * rstd0 * gv[j].w); o0[64 * j] = w; }
        if (has1) { v2u* o1 = (v2u*)(F.XN + (size_t)m1 * DM) + F.lane;
#pragma unroll
            for (int j = 0; j < 4; ++j) { v2u w; w.x = pk2(v1[j].x * rstd1 * gv[j].x, v1[j].y * rstd1 * gv[j].y); w.y = pk2(v1[j].z * rstd1 * gv[j].z, v1[j].w * rstd1 * gv[j].w); o1[64 * j] = w; } }
    }
}

__device__ __forceinline__ void p1_dt(Frame& F) {
    const int fr = F.lane & 15, fq = F.lane >> 4, w = F.wave;
    LAS float* T = (LAS float*)F.lds;
    const f32x4 bias = *(const f32x4*)(F.in[10] + 4 * fq);
    const f32x4 al = *(const f32x4*)(F.in[11] + 4 * fq);
    f32x4 av;
#pragma unroll
    for (int e = 0; e < 4; ++e) av[e] = -__expf(al[e]);
    for (int job = F.bid; job < MROWS / 128; job += F.G) {
        const int r0 = job * 128 + 16 * w;
        f32x4 acc = {0.f, 0.f, 0.f, 0.f};
        const bf16* wp = F.Wdt + (size_t)fr * 1024 + 8 * fq;
        const bf16* xp = F.XN + (size_t)(r0 + fr) * 1024 + 8 * fq;
#pragma unroll 16
        for (int kk = 0; kk < 32; ++kk) { const bf16x8 a = *(const bf16x8*)(wp + 32 * kk), b = *(const bf16x8*)(xp + 32 * kk); acc = __builtin_amdgcn_mfma_f32_16x16x32_bf16(a, b, acc, 0, 0, 0); }
        f32x4 dt, cs;
#pragma unroll
        for (int e = 0; e < 4; ++e) { const float x = acc[e] + bias[e]; const float d = x > 20.f ? x : log1pf(__expf(x)); dt[e] = d;
            float v = d * av[e];
#pragma unroll
            for (int o = 1; o < 16; o <<= 1) { const float t = __shfl_up(v, o, 16); if (fr >= o) v += t; }
            cs[e] = v; }
        if (fr == 15) *(LAS f32x4*)(T + w * 16 + 4 * fq) = cs;
        __syncthreads();
        f32x4 off = {0.f, 0.f, 0.f, 0.f}, tot = off;
#pragma unroll
        for (int q = 0; q < 4; ++q) { const int ww = (w & 4) + q; const f32x4 t = *(const LAS f32x4*)(T + ww * 16 + 4 * fq); tot += t; if (ww < w) off += t; }
        f32x4 wd;
#pragma unroll
        for (int e = 0; e < 4; ++e) { cs[e] += off[e]; wd[e] = dt[e] * __expf(tot[e] - cs[e]); }
        const size_t o = (size_t)(r0 + fr) * 16 + 4 * fq;
        *(f32x4*)(F.DT + o) = dt; *(f32x4*)(F.CS + o) = cs; *(f32x4*)(F.WD + o) = wd;
        __syncthreads();
    }
}

__device__ __forceinline__ void p2a_conv(Frame& F) {
    const int gt = F.bid * NTHR + F.tid, NGT = F.G * NTHR;
    for (int task = gt; task < 256 * 2048; task += NGT) {
        const int cgp = task & 255, seg = task >> 8, ch = cgp * 8, t0 = seg * 16;
        const bool first = (t0 & 4095) == 0;
        float w0[8], w1[8], w2[8], w3[8], cb[8];
#pragma unroll
        for (int e = 0; e < 8; ++e) { w0[e] = F.in[8][ch + e]; w1[e] = F.in[8][2048 + ch + e]; w2[e] = F.in[8][4096 + ch + e]; w3[e] = F.in[8][6144 + ch + e]; cb[e] = F.in[9][ch + e]; }
        const bf16* src = F.QKV + (size_t)t0 * NQ + X0 + ch;
        bf16* dst = (t0 < 16384 ? F.XC0 + (size_t)t0 * 2048 : F.XC1 + (size_t)(t0 - 16384) * 2048) + ch;
        float r3[8], r2[8], r1[8];
        v4u h3 = {0u, 0u, 0u, 0u}, h2 = h3, h1 = h3;
        if (!first) { h3 = *(const v4u*)(src - 3 * (size_t)NQ); h2 = *(const v4u*)(src - 2 * (size_t)NQ); h1 = *(const v4u*)(src - (size_t)NQ); }
        r3[0] = bflo(h3.x); r3[1] = bfhi(h3.x); r3[2] = bflo(h3.y); r3[3] = bfhi(h3.y); r3[4] = bflo(h3.z); r3[5] = bfhi(h3.z); r3[6] = bflo(h3.w); r3[7] = bfhi(h3.w);
        r2[0] = bflo(h2.x); r2[1] = bfhi(h2.x); r2[2] = bflo(h2.y); r2[3] = bfhi(h2.y); r2[4] = bflo(h2.z); r2[5] = bfhi(h2.z); r2[6] = bflo(h2.w); r2[7] = bfhi(h2.w);
        r1[0] = bflo(h1.x); r1[1] = bfhi(h1.x); r1[2] = bflo(h1.y); r1[3] = bfhi(h1.y); r1[4] = bflo(h1.z); r1[5] = bfhi(h1.z); r1[6] = bflo(h1.w); r1[7] = bfhi(h1.w);
        v4u rowsv[16];
#pragma unroll
        for (int l = 0; l < 16; ++l) rowsv[l] = __builtin_nontemporal_load((const v4u*)(src + (size_t)l * NQ));
#pragma unroll
        for (int l = 0; l < 16; ++l) {
            const v4u v = rowsv[l];
            float cur[8] = {bflo(v.x), bfhi(v.x), bflo(v.y), bfhi(v.y), bflo(v.z), bfhi(v.z), bflo(v.w), bfhi(v.w)};
            float o[8];
#pragma unroll
            for (int e = 0; e < 8; ++e) { const float y = w0[e] * r3[e] + w1[e] * r2[e] + w2[e] * r1[e] + w3[e] * cur[e] + cb[e]; o[e] = silu_f(y); r3[e] = r2[e]; r2[e] = r1[e]; r1[e] = cur[e]; }
            v4u ov; ov.x = pk2(o[0], o[1]); ov.y = pk2(o[2], o[3]); ov.z = pk2(o[4], o[5]); ov.w = pk2(o[6], o[7]);
            __builtin_nontemporal_store(ov, (v4u*)(dst + (size_t)l * 2048));
        }
    }
}

__device__ __forceinline__ int crow(int i, int h) { return (i & 3) + 8 * (i >> 2) + 4 * h; }
__device__ __forceinline__ void ssd_mfma_job(Frame& F, int b, int head) {
    const int tid = F.tid, lane = F.lane, wid = F.wave, r = lane & 31, h = lane >> 5, grp = head >> 2;
    LAS bf16* Xt = (LAS bf16*)F.lds;
    LAS bf16* Bn = (LAS bf16*)(F.lds + 9216);
    LAS bf16* Cn = (LAS bf16*)(F.lds + 26624);
    LAS bf16* BtS = (LAS bf16*)(F.lds + 44032);
    LAS bf16* Hb = (LAS bf16*)(F.lds + 62464);
    LAS float* Yd = (LAS float*)(F.lds + 79872);
    LAS float* Yo = (LAS float*)(F.lds + 97280);
    LAS float* csA = (LAS float*)(F.lds + 114688);
    LAS float* dtA = csA + 64;
    LAS float* Yd2 = (LAS float*)(F.lds + 115200);
    LAS float* rfA = (LAS float*)(F.lds + 123904);
    const bf16* XC = (b < 4 ? F.XC0 : F.XC1) + (size_t)((b & 3) * 4096) * 2048;
    const size_t row0 = (size_t)b * 4096;
    const float dsk = F.in[12][head];
    const bool rx = tid < 128, rb = tid >= 128 && tid < 384;
    const int xs_rseg = tid >> 3, xs_pc = tid & 7;
    const int bs_rseg = (tid - 128) >> 4, bs_pc = (tid - 128) & 15;
    const int el = tid >> 3, epg = tid & 7;
    v4u pre[4], cpre[2]; float wpre[4]; float pdt = 0.f, pcs = 0.f, pcs31 = 0.f; v4u zpre, xpre;
    f32x16 st[3];
#pragma unroll
    for (int t = 0; t < 3; ++t)
#pragma unroll
        for (int i = 0; i < 16; ++i) st[t][i] = 0.f;
    for (int i = tid; i < 17408 / 4; i += NTHR) ((LAS unsigned*)Hb)[i] = 0u;

#define SSD_PREFETCH(c) do { const int t0_ = (c) * 64; \
        if (rx) { _Pragma("unroll") for (int j = 0; j < 4; ++j) pre[j] = *(const v4u*)(XC + (size_t)(t0_ + 4 * xs_rseg + j) * 2048 + head * 64 + 8 * xs_pc); } \
        else if (rb) { _Pragma("unroll") for (int j = 0; j < 4; ++j) { pre[j] = *(const v4u*)(XC + (size_t)(t0_ + 4 * bs_rseg + j) * 2048 + 1024 + grp * 128 + 8 * bs_pc); wpre[j] = F.WD[(row0 + t0_ + 4 * bs_rseg + j) * 16 + head]; } } \
        _Pragma("unroll") for (int i = 0; i < 2; ++i) { const int id = tid + 512 * i; cpre[i] = *(const v4u*)(XC + (size_t)(t0_ + (id >> 4)) * 2048 + 1536 + grp * 128 + 8 * (id & 15)); } \
        if (tid >= 448) { pdt = F.DT[(row0 + t0_ + tid - 448) * 16 + head]; pcs = F.CS[(row0 + t0_ + tid - 448) * 16 + head]; pcs31 = F.CS[(row0 + t0_ + 31) * 16 + head]; } } while (0)
#define SSD_STAGE() do { \
        if (rx) { _Pragma("unroll") for (int e2 = 0; e2 < 4; ++e2) { v2u lo, hi; \
                _Pragma("unroll") for (int j = 0; j < 2; ++j) { const unsigned a0 = pre[2 * j][e2], a1 = pre[2 * j + 1][e2]; lo[j] = (a0 & 0xffffu) | (a1 << 16); hi[j] = (a0 >> 16) | (a1 & 0xffff0000u); } \
                *(LAS v2u*)(Xt + (8 * xs_pc + 2 * e2) * 72 + 4 * xs_rseg) = lo; *(LAS v2u*)(Xt + (8 * xs_pc + 2 * e2 + 1) * 72 + 4 * xs_rseg) = hi; } } \
        else if (rb) { _Pragma("unroll") for (int j = 0; j < 4; ++j) *(LAS v4u*)(Bn + (4 * bs_rseg + j) * 136 + 8 * bs_pc) = pre[j]; \
            _Pragma("unroll") for (int e2 = 0; e2 < 4; ++e2) { v2u lo, hi; \
                _Pragma("unroll") for (int j = 0; j < 2; ++j) { const unsigned a0 = pre[2 * j][e2], a1 = pre[2 * j + 1][e2]; \
                    lo[j] = pk2(bflo(a0) * wpre[2 * j], bflo(a1) * wpre[2 * j + 1]); hi[j] = pk2(bfhi(a0) * wpre[2 * j], bfhi(a1) * wpre[2 * j + 1]); } \
                *(LAS v2u*)(BtS + (8 * bs_pc + 2 * e2) * 72 + 4 * bs_rseg) = lo; *(LAS v2u*)(BtS + (8 * bs_pc + 2 * e2 + 1) * 72 + 4 * bs_rseg) = hi; } } \
        _Pragma("unroll") for (int i = 0; i < 2; ++i) { const int id = tid + 512 * i; *(LAS v4u*)(Cn + (id >> 4) * 136 + 8 * (id & 15)) = cpre[i]; } \
        if (tid >= 448) { dtA[tid - 448] = pdt; csA[tid - 448] = pcs; if (tid < 480) rfA[tid - 448] = __expf(pcs31 - pcs) * pdt; } } while (0)

    SSD_PREFETCH(0);
    SSD_STAGE();
    zpre = *(const v4u*)(F.QKV + (row0 + el) * NQ + Z0 + head * 64 + epg * 8);
    xpre = *(const v4u*)(XC + (size_t)el * 2048 + head * 64 + epg * 8);
    __syncthreads();
    for (int c = 0; c < 64; ++c) {
        const int t0 = c * 64;
        bf16* zp = F.QKV + (row0 + t0 + el) * NQ + Z0 + head * 64 + epg * 8;
        if (c + 1 < 64) SSD_PREFETCH(c + 1);
        if (wid < 3) {
            const int sb = wid >> 1, lb = (wid + 1) >> 1;
            f32x16 cbA, cbB;
#pragma unroll
            for (int i = 0; i < 16; ++i) { cbA[i] = 0.f; cbB[i] = 0.f; }
#pragma unroll 2
            for (int kk = 0; kk < 8; kk += 2) {
                const bf16x8 a0 = *(const LAS bf16x8*)(Bn + (32 * sb + r) * 136 + 16 * kk + 8 * h), b0 = *(const LAS bf16x8*)(Cn + (32 * lb + r) * 136 + 16 * kk + 8 * h);
                const bf16x8 a1 = *(const LAS bf16x8*)(Bn + (32 * sb + r) * 136 + 16 * kk + 16 + 8 * h), b1 = *(const LAS bf16x8*)(Cn + (32 * lb + r) * 136 + 16 * kk + 16 + 8 * h);
                cbA = MFMA32(a0, b0, cbA); cbB = MFMA32(a1, b1, cbB);
            }
            const int l = 32 * lb + r; const float csl = csA[l];
            if (sb == lb) {
#pragma unroll
                for (int ig = 0; ig < 4; ++ig) { const int s0 = 32 * sb + 8 * ig + 4 * h; const f32x4 c4 = *(const LAS f32x4*)(csA + s0), d4 = *(const LAS f32x4*)(dtA + s0);
#pragma unroll
                    for (int e = 0; e < 4; ++e) { const float f = (s0 + e) <= l ? __expf(fminf(csl - c4[e], 0.f)) * d4[e] : 0.f; cbA[4 * ig + e] = (cbA[4 * ig + e] + cbB[4 * ig + e]) * f; } }
            } else {
                const float colf = __expf(fminf(csl - csA[31], 0.f));
#pragma unroll
                for (int ig = 0; ig < 4; ++ig) { const f32x4 rf = *(const LAS f32x4*)(rfA + 8 * ig + 4 * h);
#pragma unroll
                    for (int e = 0; e < 4; ++e) cbA[4 * ig + e] = (cbA[4 * ig + e] + cbB[4 * ig + e]) * (rf[e] * colf); }
            }
            f32x16 yd0, yd1;
#pragma unroll
            for (int i = 0; i < 16; ++i) { yd0[i] = 0.f; yd1[i] = 0.f; }
#pragma unroll
            for (int stp = 0; stp < 2; ++stp) {
                v4u pw; pw.x = pk2(cbA[8 * stp + 0], cbA[8 * stp + 1]); pw.y = pk2(cbA[8 * stp + 2], cbA[8 * stp + 3]); pw.z = pk2(cbA[8 * stp + 4], cbA[8 * stp + 5]); pw.w = pk2(cbA[8 * stp + 6], cbA[8 * stp + 7]);
                const bf16x8 pf = __builtin_bit_cast(bf16x8, pw);
                const s16x4 lo0 = *(const LAS s16x4*)(Xt + r * 72 + 32 * sb + 16 * stp + 4 * h), hi0 = *(const LAS s16x4*)(Xt + r * 72 + 32 * sb + 16 * stp + 8 + 4 * h);
                const s16x4 lo1 = *(const LAS s16x4*)(Xt + (32 + r) * 72 + 32 * sb + 16 * stp + 4 * h), hi1 = *(const LAS s16x4*)(Xt + (32 + r) * 72 + 32 * sb + 16 * stp + 8 + 4 * h);
                yd0 = MFMA32(__builtin_shufflevector(lo0, hi0, 0, 1, 2, 3, 4, 5, 6, 7), pf, yd0);
                yd1 = MFMA32(__builtin_shufflevector(lo1, hi1, 0, 1, 2, 3, 4, 5, 6, 7), pf, yd1);
            }
            LAS float* dstp = (wid == 1) ? (Yd2 + r * 68) : (Yd + l * 68);
#pragma unroll
            for (int ig = 0; ig < 4; ++ig) { *(LAS f32x4*)(dstp + 8 * ig + 4 * h) = (f32x4){yd0[4 * ig], yd0[4 * ig + 1], yd0[4 * ig + 2], yd0[4 * ig + 3]};
                *(LAS f32x4*)(dstp + 32 + 8 * ig + 4 * h) = (f32x4){yd1[4 * ig], yd1[4 * ig + 1], yd1[4 * ig + 2], yd1[4 * ig + 3]}; }
        } else if (wid < 5) {
            const int lb = wid - 3, l = 32 * lb + r;
            f32x16 yo0, yo1;
#pragma unroll
            for (int i = 0; i < 16; ++i) { yo0[i] = 0.f; yo1[i] = 0.f; }
#pragma unroll 2
            for (int kk = 0; kk < 8; ++kk) {
                const bf16x8 cc = *(const LAS bf16x8*)(Cn + l * 136 + 16 * kk + 8 * h), h0 = *(const LAS bf16x8*)(Hb + r * 136 + 16 * kk + 8 * h), h1 = *(const LAS bf16x8*)(Hb + (32 + r) * 136 + 16 * kk + 8 * h);
                yo0 = MFMA32(h0, cc, yo0); yo1 = MFMA32(h1, cc, yo1);
            }
            const float elx = __expf(csA[l]);
#pragma unroll
            for (int ig = 0; ig < 4; ++ig) { *(LAS f32x4*)(Yo + l * 68 + 8 * ig + 4 * h) = (f32x4){yo0[4 * ig] * elx, yo0[4 * ig + 1] * elx, yo0[4 * ig + 2] * elx, yo0[4 * ig + 3] * elx};
                *(LAS f32x4*)(Yo + l * 68 + 32 + 8 * ig + 4 * h) = (f32x4){yo1[4 * ig] * elx, yo1[4 * ig + 1] * elx, yo1[4 * ig + 2] * elx, yo1[4 * ig + 3] * elx}; }
        } else {
            const float dec = __expf(csA[63]);
#pragma unroll
            for (int t = 0; t < 3; ++t) { const int ti = 3 * (wid - 5) + t;
                if (ti < 8) { const int pb = ti & 1, nb = ti >> 1;
#pragma unroll
                    for (int i = 0; i < 16; ++i) st[t][i] *= dec;
#pragma unroll 2
                    for (int kk = 0; kk < 4; ++kk) { const bf16x8 a = *(const LAS bf16x8*)(BtS + (32 * nb + r) * 72 + 16 * kk + 8 * h), xx = *(const LAS bf16x8*)(Xt + (32 * pb + r) * 72 + 16 * kk + 8 * h); st[t] = MFMA32(a, xx, st[t]); } } }
        }
        __syncthreads();
        {
            f32x4 a0 = *(const LAS f32x4*)(Yd + el * 68 + 8 * epg), a1 = *(const LAS f32x4*)(Yd + el * 68 + 8 * epg + 4); const f32x4 b0 = *(const LAS f32x4*)(Yo + el * 68 + 8 * epg), b1 = *(const LAS f32x4*)(Yo + el * 68 + 8 * epg + 4);
            if (el >= 32) { a0 += *(const LAS f32x4*)(Yd2 + (el - 32) * 68 + 8 * epg); a1 += *(const LAS f32x4*)(Yd2 + (el - 32) * 68 + 8 * epg + 4); }
            const float xv[8] = {bflo(xpre.x), bfhi(xpre.x), bflo(xpre.y), bfhi(xpre.y), bflo(xpre.z), bfhi(xpre.z), bflo(xpre.w), bfhi(xpre.w)};
            const float y[8] = {a0[0] + b0[0], a0[1] + b0[1], a0[2] + b0[2], a0[3] + b0[3], a1[0] + b1[0], a1[1] + b1[1], a1[2] + b1[2], a1[3] + b1[3]};
            const float z[8] = {bflo(zpre.x), bfhi(zpre.x), bflo(zpre.y), bfhi(zpre.y), bflo(zpre.z), bfhi(zpre.z), bflo(zpre.w), bfhi(zpre.w)};
            float g[8], ss = 0.f;
#pragma unroll
            for (int e = 0; e < 8; ++e) { g[e] = (y[e] + dsk * xv[e]) * silu_f(z[e]); ss += g[e] * g[e]; }
            v4u o; o.x = pk2(g[0], g[1]); o.y = pk2(g[2], g[3]); o.z = pk2(g[4], g[5]); o.w = pk2(g[6], g[7]);
            *(v4u*)zp = o;
            ss = sum8_first(ss);
            if (epg == 0) atomicAdd(F.GSS + (row0 + t0 + el) * 4 + grp, ss);
        }
        if (c + 1 < 64) {
            zpre = *(const v4u*)(F.QKV + (row0 + t0 + 64 + el) * NQ + Z0 + head * 64 + epg * 8);
            xpre = *(const v4u*)(XC + (size_t)(t0 + 64 + el) * 2048 + head * 64 + epg * 8); }
        if (wid >= 5) {
#pragma unroll
            for (int t = 0; t < 3; ++t) { const int ti = 3 * (wid - 5) + t;
                if (ti < 8) { const int pb = ti & 1, nb = ti >> 1;
#pragma unroll
                    for (int ig = 0; ig < 4; ++ig) { v2u w; w.x = pk2(st[t][4 * ig], st[t][4 * ig + 1]); w.y = pk2(st[t][4 * ig + 2], st[t][4 * ig + 3]); *(LAS v2u*)(Hb + (32 * pb + r) * 136 + 32 * nb + 8 * ig + 4 * h) = w; } } }
        }
        if (c + 1 < 64) SSD_STAGE();
        __syncthreads();
    }
#undef SSD_PREFETCH
#undef SSD_STAGE
    if (wid >= 5) {
#pragma unroll
        for (int t = 0; t < 3; ++t) { const int ti = 3 * (wid - 5) + t;
            if (ti < 8) { const int pb = ti & 1, nb = ti >> 1;
                float* so = F.out + OUT_SP + ((size_t)(b * 16 + head) * 64 + 32 * pb + r) * 128;
#pragma unroll
                for (int ig = 0; ig < 4; ++ig) *(f32x4*)(so + 32 * nb + 8 * ig + 4 * h) = (f32x4){st[t][4 * ig], st[t][4 * ig + 1], st[t][4 * ig + 2], st[t][4 * ig + 3]}; } }
    }
}

__device__ __forceinline__ void ssd_job(Frame& F, int b, int head, bool sample) {
    const int T = sample ? 16 : 4096; const int row0 = sample ? NPR + b * 16 : b * 4096;
    const int grp = head >> 2, tid = F.tid;
    LAS float* Xs = (LAS float*)F.lds;
    LAS float* Bs = Xs + 4096;
    LAS float* Cs = Bs + 8192;
    LAS float* dts = Cs + 8192;
    LAS float* dec = dts + 64;
    LAS float* Ys = dec + 64;
    const int p4 = tid >> 5, ng = tid & 31;
    float h[4][4];
    if (sample) {
#pragma unroll
        for (int i = 0; i < 4; ++i) { const f32x4 v = *(const f32x4*)(F.in[5] + ((size_t)(b * 16 + head) * 64 + 4 * p4 + i) * 128 + 4 * ng); h[i][0] = v[0]; h[i][1] = v[1]; h[i][2] = v[2]; h[i][3] = v[3]; }
    } else {
#pragma unroll
        for (int i = 0; i < 4; ++i)
#pragma unroll
            for (int j = 0; j < 4; ++j) h[i][j] = 0.f;
    }
    const float a = -__expf(F.in[11][head]), dsk = F.in[12][head];
    for (int t0 = 0; t0 < T; t0 += 64) {
        const int L = (T - t0) < 64 ? (T - t0) : 64;
        if (tid < 320) {
            const int cg8 = tid % 40, seg = tid / 40, l0 = seg * 8;
            if (l0 < L) {
                int ch; LAS float* dst; int dpitch;
                if (cg8 < 8) { ch = head * 64 + cg8 * 8; dst = Xs + cg8 * 8; dpitch = 64; }
                else if (cg8 < 24) { ch = 1024 + grp * 128 + (cg8 - 8) * 8; dst = Bs + (cg8 - 8) * 8; dpitch = 128; }
                else { ch = 1536 + grp * 128 + (cg8 - 24) * 8; dst = Cs + (cg8 - 24) * 8; dpitch = 128; }
                float w0[8], w1[8], w2[8], w3[8], cb[8];
#pragma unroll
                for (int e = 0; e < 8; ++e) { w0[e] = F.in[8][ch + e]; w1[e] = F.in[8][2048 + ch + e]; w2[e] = F.in[8][4096 + ch + e]; w3[e] = F.in[8][6144 + ch + e]; cb[e] = F.in[9][ch + e]; }
                float r3[8], r2[8], r1[8];
                auto load_row = [&](int t, float (&o)[8]) {
                    if (t >= 0) { const v4u v = *(const v4u*)(F.QKV + (size_t)(row0 + t) * NQ + X0 + ch);
                        o[0] = bflo(v.x); o[1] = bfhi(v.x); o[2] = bflo(v.y); o[3] = bfhi(v.y); o[4] = bflo(v.z); o[5] = bfhi(v.z); o[6] = bflo(v.w); o[7] = bfhi(v.w); }
                    else if (sample) { const float* sp = F.in[4] + (size_t)(b * 3 + 3 + t) * 2048 + ch;
#pragma unroll
                        for (int e = 0; e < 8; ++e) o[e] = sp[e]; }
                    else {
#pragma unroll
                        for (int e = 0; e < 8; ++e) o[e] = 0.f; }
                };
                load_row(t0 + l0 - 3, r3); load_row(t0 + l0 - 2, r2); load_row(t0 + l0 - 1, r1);
#pragma unroll
                for (int l = 0; l < 8; ++l) {
                    float cur[8];
                    if (l0 + l < L) {
                        load_row(t0 + l0 + l, cur);
#pragma unroll
                        for (int e = 0; e < 8; ++e) { const float y = w0[e] * r3[e] + w1[e] * r2[e] + w2[e] * r1[e] + w3[e] * cur[e] + cb[e]; dst[(l0 + l) * dpitch + e] = silu_f(y); }
#pragma unroll
                        for (int e = 0; e < 8; ++e) { r3[e] = r2[e]; r2[e] = r1[e]; r1[e] = cur[e]; }
                    }
                }
            }
        }
        if (tid >= 448 && tid - 448 < L) { const int l = tid - 448; const float d = F.DT[(size_t)(row0 + t0 + l) * 16 + head]; dts[l] = d; dec[l] = __expf(d * a); }
        __syncthreads();
        for (int l = 0; l < L; ++l) {
            const f32x4 xv = *(const LAS f32x4*)(Xs + l * 64 + 4 * p4);
            const f32x4 Bv = *(const LAS f32x4*)(Bs + l * 128 + 4 * ng);
            const f32x4 Cv = *(const LAS f32x4*)(Cs + l * 128 + 4 * ng);
            const float dtv = dts[l], dc = dec[l];
            float yp[4];
#pragma unroll
            for (int i = 0; i < 4; ++i) { const float xd = xv[i] * dtv; float y = 0.f;
#pragma unroll
                for (int j = 0; j < 4; ++j) { h[i][j] = dc * h[i][j] + xd * Bv[j]; y += h[i][j] * Cv[j]; }
                yp[i] = y; }
#pragma unroll
            for (int o = 16; o >= 1; o >>= 1) {
#pragma unroll
                for (int i = 0; i < 4; ++i) yp[i] += __shfl_xor(yp[i], o);
            }
            if (ng == 0) *(LAS f32x4*)(Ys + l * 64 + 4 * p4) = (f32x4){yp[0], yp[1], yp[2], yp[3]};
        }
        __syncthreads();
        {
            const int l = tid >> 3, pg = tid & 7; float ss = 0.f;
            if (l < L) {
                bf16* zp = F.QKV + (size_t)(row0 + t0 + l) * NQ + Z0 + head * 64 + pg * 8;
                const v4u zv = *(const v4u*)zp; float z[8] = {bflo(zv.x), bfhi(zv.x), bflo(zv.y), bfhi(zv.y), bflo(zv.z), bfhi(zv.z), bflo(zv.w), bfhi(zv.w)};
                float g[8];
#pragma unroll
                for (int e = 0; e < 8; ++e) { const float y = Ys[l * 64 + pg * 8 + e] + Xs[l * 64 + pg * 8 + e] * dsk; g[e] = y * silu_f(z[e]); ss += g[e] * g[e]; }
                v4u o; o.x = pk2(g[0], g[1]); o.y = pk2(g[2], g[3]); o.z = pk2(g[4], g[5]); o.w = pk2(g[6], g[7]);
                *(v4u*)zp = o;
            }
            ss += __shfl_xor(ss, 1); ss += __shfl_xor(ss, 2); ss += __shfl_xor(ss, 4);
            if (pg == 0 && l < L) atomicAdd(F.GSS + (size_t)(row0 + t0 + l) * 4 + grp, ss);
        }
        __syncthreads();
    }
    float* so = F.out + (sample ? OUT_SS : OUT_SP) + ((size_t)(b * 16 + head) * 64) * 128;
#pragma unroll
    for (int i = 0; i < 4; ++i) *(f32x4*)(so + (size_t)(4 * p4 + i) * 128 + 4 * ng) = (f32x4){h[i][0], h[i][1], h[i][2], h[i][3]};
}

constexpr int Q_SSDP = 128, Q_ATT = 2048, Q_ATS = 64;
__device__ __forceinline__ int attn_prompt_loop(Frame& F, int cur, unsigned* pollc, unsigned want) {
    const int tid = F.tid, lane = F.lane, wid = F.wave;
    LAS bf16* Ks = (LAS bf16*)F.lds;
    LAS bf16* Vt = (LAS bf16*)(F.lds + 27648);
    volatile LAS int* slot = (volatile LAS int*)(F.lds + LDS_CTL);
    const bf16* QB = F.QKV;
    const int g = wid >> 1, qh = wid & 1, r = lane & 31, h = lane >> 5;
    v4u kpre[3], vpa[2], vpb[2]; bf16x8 qpre[4];
#define ATT_LOAD(idx_) do { const int c_ = (idx_) & 63, kvh_ = ((idx_) >> 6) & 3, b_ = (idx_) >> 8; const size_t rowb_ = (size_t)b_ * 4096; const int tok0_ = (c_ - 2) * 64; \
        _Pragma("unroll") for (int i = 0; i < 3; ++i) { const int id = tid + 512 * i, rr = id >> 3, seg = id & 7, tok = tok0_ + rr; if (tok >= 0) kpre[i] = *(const v4u*)(QB + (rowb_ + tok) * NQ + K0 + kvh_ * 64 + seg * 8); } \
        _Pragma("unroll") for (int i = 0; i < 2; ++i) { const int id = tid + 512 * i; if (id < 768) { const int pr = id % 96, seg = id / 96, tok = tok0_ + 2 * pr; \
                if (tok >= 0) { vpa[i] = *(const v4u*)(QB + (rowb_ + tok) * NQ + V0 + kvh_ * 64 + seg * 8); vpb[i] = *(const v4u*)(QB + (rowb_ + tok + 1) * NQ + V0 + kvh_ * 64 + seg * 8); } } } \
        { const bf16* qp_ = QB + (rowb_ + c_ * 64 + qh * 32 + r) * NQ + Q0 + (kvh_ * 4 + g) * 64; _Pragma("unroll") for (int kk = 0; kk < 4; ++kk) qpre[kk] = *(const bf16x8*)(qp_ + 16 * kk + 8 * h); } } while (0)
    if (cur < Q_ATT) ATT_LOAD(cur);
    while (cur < Q_ATT) {
        const int c = cur & 63, kvh = (cur >> 6) & 3, b = cur >> 8;
        const int jstart = c >= 2 ? 0 : (2 - c) * 2;
        const size_t rowb = (size_t)b * 4096; const int tok0 = (c - 2) * 64;
        if (tid == 0) { slot[0] = (int)atomicAdd(F.ctl, 1u); slot[1] = (pollc && __hip_atomic_load(pollc, __ATOMIC_RELAXED, __HIP_MEMORY_SCOPE_AGENT) >= want) ? 1 : 0; }
#pragma unroll
        for (int i = 0; i < 3; ++i) { const int id = tid + 512 * i, rr = id >> 3, seg = id & 7; if (tok0 + rr >= 0) *(LAS v4u*)(Ks + rr * 72 + seg * 8) = kpre[i]; }
#pragma unroll
        for (int i = 0; i < 2; ++i) { const int id = tid + 512 * i;
            if (id < 768) { const int pr = id % 96, seg = id / 96;
                if (tok0 + 2 * pr >= 0) { LAS unsigned* vt32 = (LAS unsigned*)Vt;
#pragma unroll
                    for (int e = 0; e < 4; ++e) { const unsigned ua = vpa[i][e], ub = vpb[i][e];
                        vt32[((seg * 8 + 2 * e) * 200 + 2 * pr) >> 1] = (ua & 0xffffu) | (ub << 16);
                        vt32[((seg * 8 + 2 * e + 1) * 200 + 2 * pr) >> 1] = (ua >> 16) | (ub & 0xffff0000u); } } } }
        bf16x8 qf[4];
#pragma unroll
        for (int kk = 0; kk < 4; ++kk) qf[kk] = qpre[kk];
        const int head = kvh * 4 + g;
        bf16* qp = F.QKV + (rowb + c * 64 + qh * 32 + r) * NQ + Q0 + head * 64;
        const float sink = F.in[14][head];
        __syncthreads();
        const int nxt = slot[0]; const int stopf = slot[1];
        if (nxt < Q_ATT && !stopf) ATT_LOAD(nxt);
        f32x16 s[6];
        float mx = -INFINITY;
#pragma unroll
        for (int j = 0; j < 6; ++j) {
            if (j >= jstart) {
#pragma unroll
                for (int i = 0; i < 16; ++i) s[j][i] = 0.f;
#pragma unroll
                for (int kk = 0; kk < 4; ++kk) { const bf16x8 kf = *(const LAS bf16x8*)(Ks + (32 * j + r) * 72 + 16 * kk + 8 * h); s[j] = MFMA32(kf, qf[kk], s[j]); }
#pragma unroll
                for (int i = 0; i < 16; ++i) mx = fmaxf(mx, s[j][i]);
            }
        }
        mx = fmaxf(mx, __shfl_xor(mx, 32));
        const float m = fmaxf(mx * SCALE, sink);
        float sum = 0.f;
        f32x16 o[2];
#pragma unroll
        for (int mb = 0; mb < 2; ++mb)
#pragma unroll
            for (int i = 0; i < 16; ++i) o[mb][i] = 0.f;
#pragma unroll
        for (int j = 0; j < 6; ++j) {
            if (j >= jstart) {
#pragma unroll
                for (int i = 0; i < 16; ++i) { const float pv = __expf(s[j][i] * SCALE - m); sum += pv; s[j][i] = pv; }
#pragma unroll
                for (int st = 0; st < 2; ++st) {
                    v4u pw; pw.x = pk2(s[j][8 * st + 0], s[j][8 * st + 1]); pw.y = pk2(s[j][8 * st + 2], s[j][8 * st + 3]); pw.z = pk2(s[j][8 * st + 4], s[j][8 * st + 5]); pw.w = pk2(s[j][8 * st + 6], s[j][8 * st + 7]);
                    const bf16x8 pf = __builtin_bit_cast(bf16x8, pw);
#pragma unroll
                    for (int mb = 0; mb < 2; ++mb) { const int d = 32 * mb + r;
                        const s16x4 lo = *(const LAS s16x4*)(Vt + d * 200 + 32 * j + 16 * st + 4 * h), hi = *(const LAS s16x4*)(Vt + d * 200 + 32 * j + 16 * st + 8 + 4 * h);
                        const bf16x8 vf = __builtin_shufflevector(lo, hi, 0, 1, 2, 3, 4, 5, 6, 7);
                        o[mb] = MFMA32(vf, pf, o[mb]); }
                }
            }
        }
        sum += __shfl_xor(sum, 32);
        const float inv = 1.0f / (sum + __expf(sink - m));
#pragma unroll
        for (int mb = 0; mb < 2; ++mb)
#pragma unroll
            for (int ig = 0; ig < 4; ++ig) { v2u w; w.x = pk2(o[mb][4 * ig] * inv, o[mb][4 * ig + 1] * inv); w.y = pk2(o[mb][4 * ig + 2] * inv, o[mb][4 * ig + 3] * inv);
                *(v2u*)(qp + 32 * mb + 8 * ig + 4 * h) = w; }
        __syncthreads();
        cur = nxt;
        if (stopf) break;
    }
#undef ATT_LOAD
    return cur;
}

__device__ __forceinline__ void attn_sample_item(Frame& F, int idx) {
    const int b = idx >> 2, kvh = idx & 3, tid = F.tid, lane = F.lane, wid = F.wave, r = lane & 31, h = lane >> 5;
    LAS bf16* Ks = (LAS bf16*)F.lds;
    LAS bf16* Vt = (LAS bf16*)(F.lds + 23040);
    LAS unsigned* vt32 = (LAS unsigned*)Vt;
    const bf16* QB = F.QKV;
#pragma unroll
    for (int i = 0; i < 3; ++i) { const int id = tid + 512 * i;
        if (id < 1152) { const int j = id >> 3, seg = id & 7; v4u o;
            if (j < 128) { const float* kp = F.in[2] + ((size_t)(b * 128 + j) * 4 + kvh) * 64 + seg * 8; const f32x4 a0 = *(const f32x4*)kp, a1 = *(const f32x4*)(kp + 4);
                o.x = pk2(a0[0], a0[1]); o.y = pk2(a0[2], a0[3]); o.z = pk2(a1[0], a1[1]); o.w = pk2(a1[2], a1[3]); }
            else o = *(const v4u*)(QB + (size_t)(NPR + b * 16 + j - 128) * NQ + K0 + kvh * 64 + seg * 8);
            *(LAS v4u*)(Ks + j * 72 + seg * 8) = o; } }
#pragma unroll
    for (int i = 0; i < 2; ++i) { const int id = tid + 512 * i;
        if (id < 640) { const int pr = id % 80, seg = id / 80; v4u va, vb;
            if (pr < 64) { const float* vp = F.in[3] + ((size_t)(b * 128 + 2 * pr) * 4 + kvh) * 64 + seg * 8; const f32x4 a0 = *(const f32x4*)vp, a1 = *(const f32x4*)(vp + 4), b0 = *(const f32x4*)(vp + 256), b1 = *(const f32x4*)(vp + 260);
                va.x = pk2(a0[0], a0[1]); va.y = pk2(a0[2], a0[3]); va.z = pk2(a1[0], a1[1]); va.w = pk2(a1[2], a1[3]); vb.x = pk2(b0[0], b0[1]); vb.y = pk2(b0[2], b0[3]); vb.z = pk2(b1[0], b1[1]); vb.w = pk2(b1[2], b1[3]); }
            else if (pr < 72) { const bf16* vp = QB + (size_t)(NPR + b * 16 + 2 * pr - 128) * NQ + V0 + kvh * 64 + seg * 8; va = *(const v4u*)vp; vb = *(const v4u*)(vp + NQ); }
            else { va = (v4u){0u, 0u, 0u, 0u}; vb = va; }
#pragma unroll
            for (int e = 0; e < 4; ++e) { const unsigned ua = va[e], ub = vb[e];
                vt32[((seg * 8 + 2 * e) * 168 + 2 * pr) >> 1] = (ua & 0xffffu) | (ub << 16);
                vt32[((seg * 8 + 2 * e + 1) * 168 + 2 * pr) >> 1] = (ua >> 16) | (ub & 0xffff0000u); } } }
    __syncthreads();
    if (wid < 2) {
        const int rho = 32 * wid + r, g = rho >> 4, t = rho & 15, head = kvh * 4 + g;
        bf16* qp = F.QKV + (size_t)(NPR + b * 16 + t) * NQ + Q0 + head * 64;
        bf16x8 qf[4];
#pragma unroll
        for (int kk = 0; kk < 4; ++kk) qf[kk] = *(const bf16x8*)(qp + 16 * kk + 8 * h);
        const float sink = F.in[14][head];
        f32x16 s[5]; float mx = -INFINITY;
#pragma unroll
        for (int j = 0; j < 5; ++j) {
#pragma unroll
            for (int i = 0; i < 16; ++i) s[j][i] = 0.f;
#pragma unroll
            for (int kk = 0; kk < 4; ++kk) { const int key = j < 4 ? 32 * j + r : 128 + (r & 15); const bf16x8 kf = *(const LAS bf16x8*)(Ks + key * 72 + 16 * kk + 8 * h); s[j] = MFMA32(kf, qf[kk], s[j]); }
            if (j == 4) {
#pragma unroll
                for (int i = 0; i < 16; ++i) if (crow(i, h) >= 16) s[j][i] = -INFINITY;
            }
#pragma unroll
            for (int i = 0; i < 16; ++i) mx = fmaxf(mx, s[j][i]);
        }
        mx = fmaxf(mx, __shfl_xor(mx, 32));
        const float m = fmaxf(mx * SCALE, sink);
        float sum = 0.f; f32x16 o[2];
#pragma unroll
        for (int mb = 0; mb < 2; ++mb)
#pragma unroll
            for (int i = 0; i < 16; ++i) o[mb][i] = 0.f;
#pragma unroll
        for (int j = 0; j < 5; ++j) {
#pragma unroll
            for (int i = 0; i < 16; ++i) { const float pv = __expf(s[j][i] * SCALE - m); sum += pv; s[j][i] = pv; }
#pragma unroll
            for (int st = 0; st < 2; ++st) {
                v4u pw; pw.x = pk2(s[j][8 * st + 0], s[j][8 * st + 1]); pw.y = pk2(s[j][8 * st + 2], s[j][8 * st + 3]); pw.z = pk2(s[j][8 * st + 4], s[j][8 * st + 5]); pw.w = pk2(s[j][8 * st + 6], s[j][8 * st + 7]);
                const bf16x8 pf = __builtin_bit_cast(bf16x8, pw);
#pragma unroll
                for (int mb = 0; mb < 2; ++mb) { const int d = 32 * mb + r;
                    const s16x4 lo = *(const LAS s16x4*)(Vt + d * 168 + 32 * j + 16 * st + 4 * h), hi = *(const LAS s16x4*)(Vt + d * 168 + 32 * j + 16 * st + 8 + 4 * h);
                    const bf16x8 vf = __builtin_shufflevector(lo, hi, 0, 1, 2, 3, 4, 5, 6, 7);
                    o[mb] = MFMA32(vf, pf, o[mb]); }
            }
        }
        sum += __shfl_xor(sum, 32);
        const float inv = 1.0f / (sum + __expf(sink - m));
#pragma unroll
        for (int mb = 0; mb < 2; ++mb)
#pragma unroll
            for (int ig = 0; ig < 4; ++ig) { v2u w; w.x = pk2(o[mb][4 * ig] * inv, o[mb][4 * ig + 1] * inv); w.y = pk2(o[mb][4 * ig + 2] * inv, o[mb][4 * ig + 3] * inv);
                *(v2u*)(qp + 32 * mb + 8 * ig + 4 * h) = w; }
    }
    __syncthreads();
}

template <int EPI>
__device__ __forceinline__ void sgemm_sample(Frame& F, const bf16* A, int lda, const bf16* Bt, int K, int nItemsN, int first, int stride) {
    const int lane = F.lane, wid = F.wave, r = lane & 31, h = lane >> 5, tid = F.tid;
    LAS float* P = (LAS float*)F.lds;
    const int kper = K >> 3, k0 = wid * kper, nk = kper >> 4;
    for (int item = first; item < 4 * nItemsN; item += stride) {
        const int mi0 = item & 3, nj = item >> 2;
        int nrow0, nrow1;
        if (EPI == 3) { nrow0 = (nj >> 2) * 256 + 64 * (nj & 3); nrow1 = nrow0 + 32; } else { nrow0 = nj * 64; nrow1 = nrow0 + 32; }
        const bf16* a0 = A + (size_t)(NPR + mi0 * 64 + r) * lda + k0 + 8 * h; const bf16* a1 = a0 + (size_t)32 * lda;
        const bf16* b0 = Bt + (size_t)(nrow0 + r) * K + k0 + 8 * h; const bf16* b1 = Bt + (size_t)(nrow1 + r) * K + k0 + 8 * h;
        f32x16 acc[2][2];
#pragma unroll
        for (int ni = 0; ni < 2; ++ni)
#pragma unroll
            for (int mi = 0; mi < 2; ++mi)
#pragma unroll
                for (int i = 0; i < 16; ++i) acc[ni][mi][i] = 0.f;
#pragma unroll 4
        for (int kk = 0; kk < nk; ++kk) {
            const bf16x8 fa0 = *(const bf16x8*)(a0 + 16 * kk), fa1 = *(const bf16x8*)(a1 + 16 * kk), fb0 = *(const bf16x8*)(b0 + 16 * kk), fb1 = *(const bf16x8*)(b1 + 16 * kk);
            acc[0][0] = MFMA32(fb0, fa0, acc[0][0]); acc[0][1] = MFMA32(fb0, fa1, acc[0][1]); acc[1][0] = MFMA32(fb1, fa0, acc[1][0]); acc[1][1] = MFMA32(fb1, fa1, acc[1][1]);
        }
        LAS float* Pw = P + wid * (64 * 68);
#pragma unroll
        for (int ni = 0; ni < 2; ++ni)
#pragma unroll
            for (int mi = 0; mi < 2; ++mi)
#pragma unroll
                for (int ig = 0; ig < 4; ++ig) *(LAS f32x4*)(Pw + (32 * mi + r) * 68 + 32 * ni + 8 * ig + 4 * h) = (f32x4){acc[ni][mi][4 * ig], acc[ni][mi][4 * ig + 1], acc[ni][mi][4 * ig + 2], acc[ni][mi][4 * ig + 3]};
        __syncthreads();
        const int row = tid >> 3, grow = mi0 * 64 + row;
        if (EPI == 3) {
            const int c = (tid & 7) * 4; f32x4 g = {0.f, 0.f, 0.f, 0.f}, u = g;
#pragma unroll
            for (int w = 0; w < 8; ++w) { g += *(const LAS f32x4*)(P + w * (64 * 68) + row * 68 + c); u += *(const LAS f32x4*)(P + w * (64 * 68) + row * 68 + 32 + c); }
            const float rstd = 1.0f / sqrtf(F.SSQ1[NPR + grow] * (1.0f / 1024.0f) + EPS);
            float o[4];
#pragma unroll
            for (int e = 0; e < 4; ++e) { const float gv = g[e] * rstd, uv = u[e] * rstd; o[e] = gv * __builtin_amdgcn_rcpf(1.f + __expf(-gv)) * uv; }
            v2u w2; w2.x = pk2(o[0], o[1]); w2.y = pk2(o[2], o[3]);
            *(v2u*)(F.FFS + (size_t)grow * DFF + (nj >> 2) * 128 + 32 * (nj & 3) + c) = w2;
        } else {
            const int c0 = (tid & 7) * 8, col = nj * 64 + c0; f32x4 v0 = {0.f, 0.f, 0.f, 0.f}, v1 = v0;
#pragma unroll
            for (int w = 0; w < 8; ++w) { v0 += *(const LAS f32x4*)(P + w * (64 * 68) + row * 68 + c0); v1 += *(const LAS f32x4*)(P + w * (64 * 68) + row * 68 + c0 + 4); }
            if (EPI == 1) {
                v4u o; o.x = pk2(v0[0], v0[1]); o.y = pk2(v0[2], v0[3]); o.z = pk2(v1[0], v1[1]); o.w = pk2(v1[2], v1[3]);
                *(v4u*)(F.QKV + (size_t)(NPR + grow) * NQ + col) = o;
            } else if (EPI == 2) {
                const float* xr = F.in[1] + (size_t)grow * 1024 + col;
                v0 += *(const f32x4*)xr; v1 += *(const f32x4*)(xr + 4);
                v4u o; o.x = pk2(v0[0], v0[1]); o.y = pk2(v0[2], v0[3]); o.z = pk2(v1[0], v1[1]); o.w = pk2(v1[2], v1[3]);
                *(v4u*)(F.H1B + (size_t)(NPR + grow) * 1024 + col) = o;
                float ss = (v0[0] * v0[0] + v0[1] * v0[1]) + (v0[2] * v0[2] + v0[3] * v0[3]) + (v1[0] * v1[0] + v1[1] * v1[1]) + (v1[2] * v1[2] + v1[3] * v1[3]);
                ss += __shfl_xor(ss, 1); ss += __shfl_xor(ss, 2); ss += __shfl_xor(ss, 4);
                if ((tid & 7) == 0) atomicAdd(F.SSQ1 + NPR + grow, ss);
            } else {
                float* orow = F.out + OUT_YS + (size_t)grow * 1024 + col;
                { const v4u hw = *(const v4u*)(F.H1B + (size_t)(NPR + grow) * 1024 + col); v0 += (f32x4){bflo(hw.x), bfhi(hw.x), bflo(hw.y), bfhi(hw.y)}; v1 += (f32x4){bflo(hw.z), bfhi(hw.z), bflo(hw.w), bfhi(hw.w)}; }
                float ss = (v0[0] * v0[0] + v0[1] * v0[1]) + (v0[2] * v0[2] + v0[3] * v0[3]) + (v1[0] * v1[0] + v1[1] * v1[1]) + (v1[2] * v1[2] + v1[3] * v1[3]);
                ss += __shfl_xor(ss, 1); ss += __shfl_xor(ss, 2); ss += __shfl_xor(ss, 4);
                if ((tid & 7) == 0) atomicAdd(F.SSQ2 + NPR + grow, ss);
                asm volatile("s_waitcnt vmcnt(0)" ::: "memory");
                __syncthreads();
                unsigned* c = F.ctl + 8192 + 16 * (128 + 1 + mi0);
                if (tid == 0) { __hip_atomic_fetch_add(c, 1u, __ATOMIC_RELAXED, __HIP_MEMORY_SCOPE_AGENT);
                    unsigned sp = 0; while (__hip_atomic_load(c, __ATOMIC_RELAXED, __HIP_MEMORY_SCOPE_AGENT) < 16u) { __builtin_amdgcn_s_sleep(2); if (++sp > (1u << 20)) break; } }
                __syncthreads();
                asm volatile("" ::: "memory");
                const float rstd = 1.0f / sqrtf(__hip_atomic_load(F.SSQ2 + NPR + grow, __ATOMIC_RELAXED, __HIP_MEMORY_SCOPE_AGENT) * (1.0f / 1024.0f) + EPS);
                const f32x4 g0 = *(const f32x4*)(F.in[20] + col), g1 = *(const f32x4*)(F.in[20] + col + 4);
                *(f32x4*)orow = v0 * rstd * g0; *(f32x4*)(orow + 4) = v1 * rstd * g1;
            }
        }
        __syncthreads();
    }
}

__device__ __forceinline__ void late_weights(Frame& F) {
    LAS float* scr = (LAS float*)(F.lds + F.wave * 16384);
    const int gw = (F.bid - 128) * NWAVES + F.wave, NGW = (F.G - 128) * NWAVES;
    constexpr int I_OUT = 32 * 32, I_G = 16 * 88, I_D = 44 * 32;
    for (int it = gw; it < I_OUT + 2 * I_G + I_D; it += NGW) {
        int r = it;
        if (r < I_OUT) { const int kb = r / 32, nb = r % 32; transpose_item(F.in[15], 1024, 2048, nullptr, F.Wout, 32 * nb, 32 * nb, 64 * kb, scr, F.lane); continue; } r -= I_OUT;
        if (r < I_G) { const int kb = r / 88, nb = r % 88, n0 = 32 * nb; transpose_item(F.in[17], DFF, 1024, F.in[16], F.Wgu, (n0 >> 7) * 256 + ((n0 & 127) >> 5) * 64, n0, 64 * kb, scr, F.lane); continue; } r -= I_G;
        if (r < I_G) { const int kb = r / 88, nb = r % 88, n0 = 32 * nb; transpose_item(F.in[18], DFF, 1024, F.in[16], F.Wgu, (n0 >> 7) * 256 + ((n0 & 127) >> 5) * 64 + 32, n0, 64 * kb, scr, F.lane); continue; } r -= I_G;
        { const int kb = r / 32, nb = r % 32; transpose_item(F.in[19], 1024, DFF, nullptr, F.Wdn, 32 * nb, 32 * nb, 64 * kb, scr, F.lane); }
    }
    __syncthreads();
}
__device__ __forceinline__ void sub_arrive(Frame& F, unsigned* c) {
    asm volatile("s_waitcnt vmcnt(0)" ::: "memory");
    __syncthreads();
    if (F.tid == 0) { __builtin_amdgcn_fence(__ATOMIC_RELEASE, "agent"); asm volatile("s_waitcnt vmcnt(0)" ::: "memory"); __hip_atomic_fetch_add(c, 1u, __ATOMIC_RELAXED, __HIP_MEMORY_SCOPE_AGENT); }
}
__device__ __forceinline__ void sub_wait(Frame& F, unsigned* c, unsigned want) {
    if (F.tid == 0) {
        unsigned sp = 0; while (__hip_atomic_load(c, __ATOMIC_RELAXED, __HIP_MEMORY_SCOPE_AGENT) < want) { __builtin_amdgcn_s_sleep(2); if (++sp > (1u << 20)) break; }
        __builtin_amdgcn_fence(__ATOMIC_ACQUIRE, "agent");
        asm volatile("s_waitcnt vmcnt(0)" ::: "memory");
    }
    __syncthreads();
}
__device__ __forceinline__ void sub_barrier(Frame& F, unsigned* c, unsigned want) { sub_arrive(F, c); sub_wait(F, c, want); }
__device__ __forceinline__ void wg_arrive_wait(Frame& F, unsigned* c, unsigned want) {
    asm volatile("s_waitcnt vmcnt(0)" ::: "memory");
    __syncthreads();
    if (F.tid == 0) { __hip_atomic_fetch_add(c, 1u, __ATOMIC_RELAXED, __HIP_MEMORY_SCOPE_AGENT);
        unsigned sp = 0; while (__hip_atomic_load(c, __ATOMIC_RELAXED, __HIP_MEMORY_SCOPE_AGENT) < want) { __builtin_amdgcn_s_sleep(2); if (++sp > (1u << 20)) break; } }
    __syncthreads();
    asm volatile("" ::: "memory");
}
__device__ __forceinline__ void norm_rows(Frame& F, size_t row0, int nrows, int ch0, int cgn_log2, int grp) {
    const int cgn = 1 << cgn_log2, tid = F.tid, rows_per_pass = NTHR >> cgn_log2;
    const int cg = tid & (cgn - 1), rr = tid >> cgn_log2, ch = ch0 + 8 * cg;
    const f32x4 wa = *(const f32x4*)(F.in[13] + ch), wb = *(const f32x4*)(F.in[13] + ch + 4);
    __builtin_amdgcn_fence(__ATOMIC_ACQUIRE, "agent");
    for (int r0 = rr; r0 < nrows; r0 += 8 * rows_per_pass) {
        v4u xv[8]; float sv[8];
#pragma unroll
        for (int u = 0; u < 8; ++u) { const int r = r0 + u * rows_per_pass; if (r < nrows) { xv[u] = *(const v4u*)(F.QKV + (row0 + r) * NQ + Z0 + ch); sv[u] = F.GSS[(row0 + r) * 4 + grp]; } }
#pragma unroll
        for (int u = 0; u < 8; ++u) { const int r = r0 + u * rows_per_pass;
            if (r < nrows) { const float rstd = __builtin_amdgcn_rsqf(sv[u] * (1.0f / 256.0f) + EPS); const v4u x = xv[u];
                v4u o; o.x = pk2(bflo(x.x) * rstd * wa[0], bfhi(x.x) * rstd * wa[1]); o.y = pk2(bflo(x.y) * rstd * wa[2], bfhi(x.y) * rstd * wa[3]);
                o.z = pk2(bflo(x.z) * rstd * wb[0], bfhi(x.z) * rstd * wb[1]); o.w = pk2(bflo(x.w) * rstd * wb[2], bfhi(x.w) * rstd * wb[3]);
                *(v4u*)(F.QKV + (row0 + r) * NQ + Z0 + ch) = o; } }
    }
}
__device__ __forceinline__ void p2_mixers(Frame& F) {
    if (F.bid < Q_SSDP) {
        const int b = F.bid >> 4, head = F.bid & 15, grp = head >> 2;
        ssd_mfma_job(F, b, head);
        wg_arrive_wait(F, F.ctl + 64 + 16 * (b * 4 + grp), 4u);
        norm_rows(F, (size_t)b * 4096, 4096, head * 64, 3, grp);
    } else {
        late_weights(F);
        const int j = F.bid - Q_SSDP, b = j >> 3, grp = (j >> 1) & 3, half = j & 1;
#pragma unroll 1
        for (int hh = 0; hh < 2; ++hh) { ssd_job(F, b, grp * 4 + 2 * half + hh, true); __syncthreads(); }
        wg_arrive_wait(F, F.ctl + 12288 + 16 * (b * 4 + grp), 2u);
        norm_rows(F, (size_t)NPR + b * 16, 16, (grp * 4 + 2 * half) * 64, 4, grp);
        const int gt = j * NTHR + F.tid, NGT = (F.G - Q_SSDP) * NTHR;
        for (int i = gt; i < 8 * 128 * 256; i += NGT) { const int c = i & 255, jj = (i >> 8) & 127, bb = i >> 15; const size_t row = (size_t)bb * 4096 + 3968 + jj;
            F.out[OUT_KP + i] = bflo(F.QKV[row * NQ + K0 + c]); F.out[OUT_VP + i] = bflo(F.QKV[row * NQ + V0 + c]); }
        for (int i = gt; i < 8 * 3 * 2048; i += NGT) { const int c = i & 2047, jj = (i >> 11) % 3, bb = i / 6144; const size_t row = (size_t)bb * 4096 + 4093 + jj;
            F.out[OUT_CP + i] = bflo(F.QKV[row * NQ + X0 + c]); }
        for (int i = gt; i < 16 * 16 * 256; i += NGT) { const int c = i & 255, rr = i >> 8; const size_t row = (size_t)NPR + rr;
            F.out[OUT_KS + i] = bflo(F.QKV[row * NQ + K0 + c]); F.out[OUT_VS + i] = bflo(F.QKV[row * NQ + V0 + c]); }
        for (int i = gt; i < 16 * 3 * 2048; i += NGT) { const int c = i & 2047, jj = (i >> 11) % 3, bb = i / 6144; const size_t row = (size_t)NPR + bb * 16 + 13 + jj;
            F.out[OUT_CS + i] = bflo(F.QKV[row * NQ + X0 + c]); }
    }
    volatile LAS int* slot = (volatile LAS int*)(F.lds + LDS_CTL);
    int item = Q_ATT;
    if (F.bid >= Q_SSDP) {
        const int sb_first = F.bid - Q_SSDP, sb_n = F.G - Q_SSDP;
        __syncthreads();
        for (int it = sb_first; it < Q_ATS; it += sb_n) attn_sample_item(F, it);
        sub_arrive(F, F.ctl + 32);
        __syncthreads();
        if (F.tid == 0) slot[0] = (int)atomicAdd(F.ctl, 1u);
        __syncthreads();
        item = slot[0];
        __syncthreads();
        item = attn_prompt_loop(F, item, F.ctl + 32, (unsigned)sb_n);
        sub_wait(F, F.ctl + 32, (unsigned)sb_n);
        sgemm_sample<2>(F, F.QKV, NQ, F.Wout, 2048, 1024 / 64, sb_first, sb_n);
        sub_barrier(F, F.ctl + 32, 2u * (unsigned)sb_n);
        sgemm_sample<3>(F, F.H1B, 1024, F.Wgu, 1024, 2 * DFF / 64, sb_first, sb_n);
        sub_barrier(F, F.ctl + 32, 3u * (unsigned)sb_n);
        sgemm_sample<4>(F, F.FFS - (size_t)NPR * DFF, DFF, F.Wdn, DFF, 1024 / 64, sb_first, sb_n);
        __syncthreads();
    } else {
        __syncthreads();
        if (F.tid == 0) slot[0] = (int)atomicAdd(F.ctl, 1u);
        __syncthreads();
        item = slot[0];
        __syncthreads();
    }
    item = attn_prompt_loop(F, item, nullptr, 0u);
}

__global__ void __launch_bounds__(NTHR, 2) fwd_mega(Args args) {
    extern __shared__ __attribute__((aligned(16))) unsigned char lds[];
    Frame F;
    F.lds = (LAS unsigned char*)lds;
    F.tid = threadIdx.x; F.lane = F.tid & 63; F.wave = __builtin_amdgcn_readfirstlane(F.tid >> 6);
    F.G = gridDim.x; F.bid = blockIdx.x;
#pragma unroll
    for (int i = 0; i < 21; ++i) F.in[i] = args.in[i];
    F.out = args.out; F.ws = args.ws;
    unsigned char* ws = args.ws;
    F.ctl = (unsigned*)(ws + WS_CTL);
    F.Win = (bf16*)(ws + WS_WIN); F.Wdt = (bf16*)(ws + WS_WDT); F.Wout = (bf16*)(ws + WS_WOUT); F.Wgu = (bf16*)(ws + WS_WGU); F.Wdn = (bf16*)(ws + WS_WDN);
    F.SSQ1 = (float*)(ws + WS_SSQ1); F.SSQ2 = (float*)(ws + WS_SSQ2); F.GSS = (float*)(ws + WS_GSS); F.DT = (float*)(ws + WS_DT); F.CS = (float*)(ws + WS_CS); F.WD = (float*)(ws + WS_WD); F.XC1 = (bf16*)(ws + WS_XC1); F.FFS = (bf16*)(ws + WS_FFS);
    F.XN = (bf16*)(ws + WS_XN); F.H1B = F.XN; F.XC0 = F.XN; F.QKV = (bf16*)(ws + WS_QKV); F.FF = F.QKV;
    const int lo = args.ph_lo, hi = args.ph_hi;
    volatile LAS unsigned* MISC = (volatile LAS unsigned*)(F.lds + LDS_CTL + 64);
    if (F.tid < 2) MISC[F.tid] = 0u;
    __syncthreads();
    XcdBarrier bar; bar.bar = F.ctl + 1024; bar.x = 0; bar.st = MISC;
    if (hi - lo > 1) bar = xcd_barrier_post(F.ctl + 1024, MISC);
#define IN(k) (lo <= (k) && (k) < hi)
#define SEAM(k) do { if (IN(k) && IN((k) + 1)) { xcd_barrier(bar); } } while (0)
    if (lo < 0) cg::this_grid().sync();

    if (IN(0)) { p0_prologue(F); } SEAM(0);
    if (IN(1)) {
        pg8::Gemm g{F.XN, F.Win, NPR, NQ, 1024, 1024}; pg8::StaticOrder S; S.init(NPR, NQ, F.G, F.bid);
        pg8::EpiBf16<0> E{F.QKV, NQ, nullptr, 0, 0, 1.f};
        const bool side_first = ((F.bid >> 3) & 1) != 0;
        if (side_first) { sgemm_sample<1>(F, F.XN, 1024, F.Win, 1024, NQ / 64, F.bid, F.G); p1_dt(F); }
        pg8::gemm_phase<pg8::EpiBf16<0>, pg8::StaticOrder, true, true>(F.lds, g, S, E);
        if (!side_first) { sgemm_sample<1>(F, F.XN, 1024, F.Win, 1024, NQ / 64, F.bid, F.G); p1_dt(F); }
    } SEAM(1);
    if (IN(2)) { p2a_conv(F); } SEAM(2);
    if (IN(3)) { p2_mixers(F); } SEAM(3);
    if (IN(4)) {
        pg8::Gemm g{F.QKV, F.Wout, NPR, 1024, 2048, NQ}; pg8::StaticOrder S; S.init(NPR, 1024, F.G, F.bid);
        pg8::EpiRes1 E{F.in[0], F.in[1], F.out, F.H1B, F.SSQ1};
        pg8::gemm_phase<pg8::EpiRes1, pg8::StaticOrder, true, true>(F.lds, g, S, E);
    } SEAM(4);
    if (IN(5)) {
        pg8::Gemm g{F.H1B, F.Wgu, NPR, 2 * DFF, 1024, 1024}; pg8::StaticOrder S; S.init(NPR, 2 * DFF, F.G, F.bid);
        pg8::EpiSwiGLU E{F.SSQ1, F.FF};
        pg8::gemm_phase<pg8::EpiSwiGLU, pg8::StaticOrder, true, true>(F.lds, g, S, E);
    } SEAM(5);
    if (IN(6)) {
        pg8::Gemm g{F.FF, F.Wdn, NPR, 1024, DFF, DFF}; pg8::StaticOrder S; S.init(NPR, 1024, F.G, F.bid);
        pg8::EpiFinal E{F.out, F.H1B, F.in[20], F.SSQ2, F.ctl + 8192};
        pg8::gemm_phase<pg8::EpiFinal, pg8::StaticOrder, true, true>(F.lds, g, S, E);
    }
#undef IN
#undef SEAM
}

extern "C" void kernel_launch(void* const* d_in, const int* in_sizes, int n_in, void* d_out, int out_size, void* d_ws, size_t ws_size, hipStream_t stream) {
    static int grid = 0;
    if (grid == 0) {
        if (n_in != 21 || ws_size < WS_END) { fprintf(stderr, "kernel_launch: unexpected n_in %d / ws %zu\n", n_in, ws_size); grid = -1; return; }
        int dev = 0, cus = 0, per_cu = 0;
        hipGetDevice(&dev); hipDeviceGetAttribute(&cus, hipDeviceAttributeMultiprocessorCount, dev);
        if (hipFuncSetAttribute((const void*)fwd_mega, hipFuncAttributeMaxDynamicSharedMemorySize, LDS_BYTES) != hipSuccess) { fprintf(stderr, "kernel_launch: hipFuncSetAttribute failed\n"); grid = -1; return; }
        if (hipOccupancyMaxActiveBlocksPerMultiprocessor(&per_cu, (const void*)fwd_mega, NTHR, LDS_BYTES) != hipSuccess || per_cu < 1) { fprintf(stderr, "kernel_launch: occupancy query says %d\n", per_cu); per_cu = 1; }
        (void)hipGetLastError();
        grid = cus * per_cu;
        fprintf(stderr, "kernel_launch: grid %d (cus %d x %d)\n", grid, cus, per_cu);
    }
    if (grid < 0) return;
    if (hipMemsetAsync((char*)d_ws + WS_CTL, 0, 65536, stream) != hipSuccess) { fprintf(stderr, "kernel_launch: memset failed\n"); return; }
    Args a{};
    for (int i = 0; i < 21; ++i) a.in[i] = (const float*)d_in[i];
    a.out = (float*)d_out; a.ws = (unsigned char*)d_ws;
#if MK_MULTI
    for (int ph = 0; ph < NPHASE; ++ph) { a.ph_lo = ph; a.ph_hi = ph + 1; hipLaunchKernelGGL(fwd_mega, dim3(grid), dim3(NTHR), LDS_BYTES, stream, a); }
#else
    a.ph_lo = 0; a.ph_hi = NPHASE;
    void* kargs[] = {&a};
    hipError_t e = hipLaunchCooperativeKernel((const void*)fwd_mega, dim3(grid), dim3(NTHR), kargs, LDS_BYTES, stream);
    if (e != hipSuccess) fprintf(stderr, "kernel_launch: cooperative launch failed: %s (grid %d)\n", hipGetErrorString(e), grid);
#endif
}
```

```cpp
#include <hip/hip_runtime.h>
#include <hip/hip_cooperative_groups.h>
#include <cstdio>
#include <cstdint>
namespace cg = cooperative_groups;
namespace pg8 {
#define PG8_LAS __attribute__((address_space(3)))
typedef unsigned short bf16_t;
typedef short bf16x8 __attribute__((ext_vector_type(8)));
typedef float f32x4 __attribute__((ext_vector_type(4)));
typedef unsigned u32x4 __attribute__((ext_vector_type(4)));
constexpr int BM = 256, BK = 64, HALF = 128, HTB = HALF * BK * 2  , STAGE_BYTES = 8 * HTB, NXCD = 8, WGM = 8;

__host__ __device__ __forceinline__ int lds_byte(int r, int c) { const int st = (r >> 4) * 2 + (c >> 5), rr = r & 15, cc = c & 31, ob = rr * 64 + cc * 2; return st * 1024 + (ob ^ (((ob >> 9) & 1) << 5)); }
__host__ __device__ __forceinline__ void stage_rc(int b, int& R, int& C) { const int st = b / 1024, sb = b % 1024, swz = sb ^ (((sb >> 9) & 1) << 5); R = (st >> 1) * 16 + swz / 64; C = (st & 1) * 32 + (swz % 64) / 2; }
__host__ __device__ __forceinline__ int perm32(int rho) { const int n = rho >> 4, i = rho & 15; return 8 * (i >> 2) + 4 * n + (i & 3); }

struct Unit { int pm, pn; };
struct Gemm { const bf16_t* A; const bf16_t* Bt; int M, N, K, lda; };

struct StaticOrder {
    int nM, nN, nwg, G, c;
    __host__ __device__ void init(int M, int N, int G_, int c_) { nM = M / BM; nN = N / BM; nwg = nM * nN; G = G_; c = c_; }
    __host__ __device__ bool next(int i, Unit& u) const {
        const long L = (long)i * G + c; if (L >= nwg) return false;
        int wgid = (int)L; { const int q = nwg / NXCD, r = nwg % NXCD, xcd = wgid % NXCD, off = wgid / NXCD; wgid = (xcd < r ? xcd * (q + 1) : r * (q + 1) + (xcd - r) * q) + off; }
        const int nig = WGM * nN, gid = wgid / nig, fm = gid * WGM, gsz = (nM - fm) < WGM ? (nM - fm) : WGM;
        u.pm = fm + ((wgid % nig) % gsz); u.pn = (wgid % nig) / gsz; return true;
    }
    __device__ __forceinline__ void a_ready(const Unit&) const {}
    __device__ __forceinline__ void done(const Unit&) const {}
};

__device__ __forceinline__ unsigned cvt_pk_bf16(float lo, float hi) { typedef __bf16 bf2v __attribute__((ext_vector_type(2))); typedef float f2v __attribute__((ext_vector_type(2))); const f2v v = {lo, hi}; return __builtin_bit_cast(unsigned, __builtin_convertvector(v, bf2v)); }
typedef float f32x2 __attribute__((ext_vector_type(2)));
__device__ __forceinline__ f32x2 gelu_pk(f32x2 v) {
    const f32x2 av = __builtin_elementwise_abs(v), d = av * 0.2316418882f + 1.0f;
    f32x2 t; t.x = __builtin_amdgcn_rcpf(d.x); t.y = __builtin_amdgcn_rcpf(d.y);
    f32x2 q = t * 0.5307027145f + (-0.7265760135f); q = q * t + 0.7107068705f; q = q * t + (-0.142248368f); q = q * t + 0.127414796f; q = q * t;
    const f32x2 s = (v * v) * (-0.72134752044f);
    f32x2 e; e.x = __builtin_amdgcn_exp2f(s.x); e.y = __builtin_amdgcn_exp2f(s.y);
    const f32x2 m = v * (q * e), r = v - m;
    f32x2 o; o.x = v.x < 0.f ? m.x : r.x; o.y = v.y < 0.f ? m.y : r.y; return o;
}

template <int ACT  > struct EpiBf16 {
    static constexpr bool PERM = true, AFTER_DRAIN = false; static_assert(ACT == 0 || ACT == 1, "EpiBf16: ACT is 0 (none) or 1 (gelu_pk)");
    bf16_t* O; int ldc; const float* bias; int split_cols; size_t split_stride; float scale0;
    __device__ __forceinline__ void operator()(const f32x4 (&acc)[2][2][4][2], const Unit& u, int wr, int wc, int fr, int fq) const {
        const int row0 = u.pm * BM + wr * 64 + fr; int colt = u.pn * BM; bf16_t* base = O;
        float sc = 1.f; if (split_cols) { const int t = colt / split_cols; base += (size_t)t * split_stride; colt -= t * split_cols; if (t == 0) sc = scale0; }
        const int col0 = colt + wc * 64 + 8 * fq, bcol0 = u.pn * BM + wc * 64 + 8 * fq;
        f32x4 bv[2][2];
#pragma unroll
        for (int bj = 0; bj < 2; ++bj)
#pragma unroll
            for (int n = 0; n < 2; ++n) bv[bj][n] = bias ? *(const f32x4*)(bias + bcol0 + bj * 32 + 4 * n) : (f32x4){0.f, 0.f, 0.f, 0.f};
#pragma unroll
        for (int ai = 0; ai < 2; ++ai)
#pragma unroll
            for (int m = 0; m < 4; ++m) { bf16_t* rowp = base + (size_t)(row0 + ai * HALF + m * 16) * ldc + col0;
#pragma unroll
                for (int bj = 0; bj < 2; ++bj) { f32x4 v0 = acc[ai][bj][m][0] + bv[bj][0], v1 = acc[ai][bj][m][1] + bv[bj][1];
                    if (ACT == 1) { f32x2 a = gelu_pk((f32x2){v0[0], v0[1]}), b = gelu_pk((f32x2){v0[2], v0[3]}), c = gelu_pk((f32x2){v1[0], v1[1]}), d = gelu_pk((f32x2){v1[2], v1[3]});
                        v0 = (f32x4){a.x, a.y, b.x, b.y}; v1 = (f32x4){c.x, c.y, d.x, d.y}; }
                    v0 = v0 * sc; v1 = v1 * sc; u32x4 w; w.x = cvt_pk_bf16(v0[0], v0[1]); w.y = cvt_pk_bf16(v0[2], v0[3]); w.z = cvt_pk_bf16(v1[0], v1[1]); w.w = cvt_pk_bf16(v1[2], v1[3]);
                    __builtin_nontemporal_store(w, (u32x4*)(rowp + bj * 32)); } }
    }
};

template <class Epi, class Sched, bool ALIGN_EPI = false, bool SP2 = false>
__device__ __forceinline__ void gemm_phase(PG8_LAS unsigned char* lds, const Gemm g, const Sched& S, const Epi& E) {
    const int tid = threadIdx.x, wid = __builtin_amdgcn_readfirstlane(tid >> 6), lane = tid & 63, wr = wid >> 2, wc = wid & 3, fr = lane & 15, fq = lane >> 4;
    const int K = g.K, nt = K / BK;
    unsigned voffA[2], voffB[2];
#pragma unroll
    for (int i = 0; i < 2; ++i) { int R, C; stage_rc(tid * 16 + i * 8192, R, C); const int Rb = Epi::PERM ? (64 * (R >> 5) + perm32(R & 31)) : R;
        voffA[i] = (unsigned)(R * g.lda + C) * 2u; voffB[i] = (unsigned)(Rb * K + C) * 2u; }
    const size_t kstep = (size_t)(BK * 2);
    const size_t hstepB = (size_t)(Epi::PERM ? 32 : HALF) * K * 2, hstepA = (size_t)HALF * g.lda * 2;
    const size_t tstepA = 2 * hstepA, tstepB = (size_t)BM * K * 2;
    const unsigned ldsw = (unsigned)wid * 1024u;
    const int aoff = lds_byte(wr * 64 + fr, fq * 8), boff = lds_byte(wc * 32 + fr, fq * 8);
#define PG8_SA(b, h) (((b) * 2 + (h)) * HTB)
#define PG8_SB(b, h) ((4 + (b) * 2 + (h)) * HTB)
#define PG8_STAGE(bufoff, gbase, voff) do { _Pragma("unroll") for (int _i = 0; _i < 2; ++_i) \
        __builtin_amdgcn_global_load_lds((const unsigned*)((const char*)(gbase) + (voff)[_i]), (PG8_LAS unsigned*)(lds + (bufoff) + ldsw + _i * 8192), 16, 0, 0); } while (0)
#define PG8_LDA(dst, b, h) do { _Pragma("unroll") for (int m = 0; m < 4; ++m) _Pragma("unroll") for (int k = 0; k < 2; ++k) dst[m][k] = *(const PG8_LAS bf16x8*)(lds + PG8_SA(b, h) + aoff + m * 2048 + k * 1024); } while (0)
#define PG8_LDB(dst, b, h) do { _Pragma("unroll") for (int n = 0; n < 2; ++n) _Pragma("unroll") for (int k = 0; k < 2; ++k) dst[n][k] = *(const PG8_LAS bf16x8*)(lds + PG8_SB(b, h) + boff + n * 2048 + k * 1024); } while (0)
#define PG8_MMA(ai, bj, At, Bt) do { __builtin_amdgcn_s_setprio(1); _Pragma("unroll") for (int m = 0; m < 4; ++m) _Pragma("unroll") for (int n = 0; n < 2; ++n) _Pragma("unroll") for (int k = 0; k < 2; ++k) \
        acc[ai][bj][m][n] = __builtin_amdgcn_mfma_f32_16x16x32_bf16(Bt[n][k], At[m][k], acc[ai][bj][m][n], 0, 0, 0); __builtin_amdgcn_s_setprio(0); } while (0)
#define PG8_WAIT_V(n) asm volatile("s_waitcnt vmcnt(" #n ")" ::: "memory")
#define PG8_WAIT_L(n) asm volatile("s_waitcnt lgkmcnt(" #n ")" ::: "memory")
#define PG8_BAR __builtin_amdgcn_s_barrier()
#define PG8_SCHED __builtin_amdgcn_sched_barrier(0)
    Unit cur, nxt; int ui = 0;
    if (!S.next(0, cur)) return;
    f32x4 acc[2][2][4][2];
#pragma unroll
    for (int a = 0; a < 2; ++a)
#pragma unroll
        for (int b = 0; b < 2; ++b)
#pragma unroll
            for (int m = 0; m < 4; ++m)
#pragma unroll
                for (int n = 0; n < 2; ++n) acc[a][b][m][n] = (f32x4){0.f, 0.f, 0.f, 0.f};
    bf16x8 At[4][2], B0[2][2], B1[2][2];
    const char* cA = (const char*)g.A + (size_t)cur.pm * tstepA; const char* cB = (const char*)g.Bt + (size_t)cur.pn * tstepB;
    S.a_ready(cur);
    if constexpr (SP2) {
        PG8_STAGE(PG8_SB(0, 0), cB, voffB); PG8_STAGE(PG8_SB(0, 1), cB + hstepB, voffB); PG8_STAGE(PG8_SA(0, 0), cA, voffA); PG8_STAGE(PG8_SA(0, 1), cA + hstepA, voffA);
        if (wr == 1) PG8_BAR;
        PG8_WAIT_V(2); PG8_BAR;
        PG8_STAGE(PG8_SB(1, 0), cB + kstep, voffB); PG8_STAGE(PG8_SA(1, 0), cA + kstep, voffA); PG8_STAGE(PG8_SB(1, 1), cB + hstepB + kstep, voffB);
        PG8_WAIT_V(6); PG8_BAR;
    } else {
        PG8_STAGE(PG8_SB(0, 0), cB, voffB); PG8_STAGE(PG8_SA(0, 0), cA, voffA); PG8_STAGE(PG8_SB(0, 1), cB + hstepB, voffB); PG8_STAGE(PG8_SA(0, 1), cA + hstepA, voffA);
        if (wr == 1) PG8_BAR;
        PG8_WAIT_V(4); PG8_BAR;
        PG8_STAGE(PG8_SB(1, 0), cB + kstep, voffB); PG8_STAGE(PG8_SA(1, 0), cA + kstep, voffA); PG8_STAGE(PG8_SB(1, 1), cB + hstepB + kstep, voffB);
        PG8_WAIT_V(6); PG8_BAR;
    }
    for (;;) {
        const bool has_next = S.next(ui + 1, nxt);
        const char* nA = has_next ? (const char*)g.A + (size_t)nxt.pm * tstepA : cA; const char* nB = has_next ? (const char*)g.Bt + (size_t)nxt.pn * tstepB : cB;
        for (int t = 0; t < nt; t += 2) {
            const bool last = (t == nt - 2);
            const char* a1 = cA + (size_t)(t + 1) * kstep;
            const char* a2 = last ? nA : cA + (size_t)(t + 2) * kstep; const char* b2 = last ? nB : cB + (size_t)(t + 2) * kstep;
            const char* a3 = a2 + kstep; const char* b3 = b2 + kstep;
            if (last && has_next) S.a_ready(nxt);
            if constexpr (SP2) {
            PG8_LDB(B0, 0, 0); PG8_LDB(B1, 0, 1); PG8_SCHED; PG8_LDA(At, 0, 0); PG8_STAGE(PG8_SA(1, 1), a1 + hstepA, voffA);
            PG8_WAIT_V(8); PG8_WAIT_L(0); PG8_BAR; PG8_MMA(0, 0, At, B0); PG8_MMA(0, 1, At, B1); PG8_BAR; PG8_SCHED;
            PG8_LDA(At, 0, 1); PG8_STAGE(PG8_SB(0, 0), b2, voffB); PG8_STAGE(PG8_SB(0, 1), b2 + hstepB, voffB); PG8_STAGE(PG8_SA(0, 0), a2, voffA);
            PG8_WAIT_V(8); PG8_WAIT_L(0); PG8_BAR; PG8_MMA(1, 0, At, B0); PG8_MMA(1, 1, At, B1); PG8_BAR; PG8_SCHED;
            PG8_LDB(B0, 1, 0); PG8_LDB(B1, 1, 1); PG8_SCHED; PG8_LDA(At, 1, 0); PG8_STAGE(PG8_SA(0, 1), a2 + hstepA, voffA);
            PG8_WAIT_V(8); PG8_WAIT_L(0); PG8_BAR; PG8_MMA(0, 0, At, B0); PG8_MMA(0, 1, At, B1); PG8_BAR; PG8_SCHED;
            PG8_LDA(At, 1, 1); PG8_STAGE(PG8_SB(1, 0), b3, voffB); PG8_STAGE(PG8_SB(1, 1), b3 + hstepB, voffB); PG8_STAGE(PG8_SA(1, 0), a3, voffA);
            PG8_WAIT_V(8); PG8_WAIT_L(0); PG8_BAR; PG8_MMA(1, 0, At, B0); PG8_MMA(1, 1, At, B1); PG8_BAR; PG8_SCHED;
            } else {
            PG8_LDB(B0, 0, 0); PG8_SCHED; PG8_LDA(At, 0, 0); PG8_STAGE(PG8_SA(1, 1), a1 + hstepA, voffA);
            PG8_WAIT_L(8); PG8_BAR; PG8_WAIT_L(0); PG8_MMA(0, 0, At, B0); PG8_BAR; PG8_SCHED;
            PG8_LDB(B1, 0, 1); PG8_STAGE(PG8_SB(0, 0), b2, voffB);
            PG8_BAR; PG8_WAIT_L(0); PG8_MMA(0, 1, At, B1); PG8_BAR;
            PG8_LDA(At, 0, 1); PG8_STAGE(PG8_SA(0, 0), a2, voffA);
            PG8_BAR; PG8_WAIT_L(0); PG8_MMA(1, 0, At, B0); PG8_BAR; PG8_SCHED;
            PG8_STAGE(PG8_SB(0, 1), b2 + hstepB, voffB);
            PG8_WAIT_V(6); PG8_BAR; PG8_MMA(1, 1, At, B1); PG8_BAR;
            PG8_LDB(B0, 1, 0); PG8_SCHED; PG8_LDA(At, 1, 0); PG8_STAGE(PG8_SA(0, 1), a2 + hstepA, voffA);
            PG8_WAIT_L(8); PG8_BAR; PG8_WAIT_L(0); PG8_MMA(0, 0, At, B0); PG8_BAR; PG8_SCHED;
            PG8_LDB(B1, 1, 1); PG8_STAGE(PG8_SB(1, 0), b3, voffB);
            PG8_BAR; PG8_WAIT_L(0); PG8_MMA(0, 1, At, B1); PG8_BAR;
            PG8_LDA(At, 1, 1); PG8_STAGE(PG8_SA(1, 0), a3, voffA);
            PG8_BAR; PG8_WAIT_L(0); PG8_MMA(1, 0, At, B0); PG8_BAR; PG8_SCHED;
            PG8_STAGE(PG8_SB(1, 1), b3 + hstepB, voffB);
            PG8_WAIT_V(6); PG8_BAR; PG8_MMA(1, 1, At, B1); PG8_BAR;
            }
        }
        if constexpr (ALIGN_EPI) { if (wr == 0) PG8_BAR; }
        if constexpr (!Epi::AFTER_DRAIN) { E(acc, cur, wr, wc, fr, fq); S.done(cur); }
        if (!has_next) break;
#pragma unroll
        for (int a = 0; a < 2; ++a)
#pragma unroll
            for (int b = 0; b < 2; ++b)
#pragma unroll
                for (int m = 0; m < 4; ++m)
#pragma unroll
                    for (int n = 0; n < 2; ++n) acc[a][b][m][n] = (f32x4){0.f, 0.f, 0.f, 0.f};
        cur = nxt; cA = nA; cB = nB; ++ui;
        if constexpr (ALIGN_EPI) { if (wr == 1) PG8_BAR; }
    }
    PG8_WAIT_V(0);
    if constexpr (!ALIGN_EPI) { if (wr == 0) PG8_BAR; }
    PG8_BAR;
    if constexpr (Epi::AFTER_DRAIN) { E.fused(acc, cur, wr, wc, fr, fq, lds, wid, lane); S.done(cur); }
#undef PG8_SA
#undef PG8_SB
#undef PG8_STAGE
#undef PG8_LDA
#undef PG8_LDB
#undef PG8_MMA
#undef PG8_WAIT_V
#undef PG8_WAIT_L
#undef PG8_BAR
#undef PG8_SCHED
}
}

#ifndef MK_MULTI
#define MK_MULTI 0
#endif
#define LAS __attribute__((address_space(3)))
typedef unsigned short bf16;
typedef unsigned v4u __attribute__((ext_vector_type(4)));
typedef unsigned v2u __attribute__((ext_vector_type(2)));
typedef float f32x4 __attribute__((ext_vector_type(4)));
typedef float f32x16 __attribute__((ext_vector_type(16)));
typedef short bf16x8 __attribute__((ext_vector_type(8)));
typedef short s16x4 __attribute__((ext_vector_type(4)));

constexpr int NWAVES = 8, NTHR = 512;
constexpr int DM = 1024, NPR = 32768, NSR = 256, MROWS = NPR + NSR;
constexpr int NQ = 4608;
constexpr int Q0 = 0, Z0 = 1024, K0 = 2048, V0 = 2304, X0 = 2560;
constexpr int DIN = 4624, DFF = 2816;
constexpr float EPS = 1e-6f, SCALE = 0.125f;
constexpr int NPHASE = 7;

constexpr size_t MiB = 1u << 20;
constexpr size_t WS_CTL = 0, WS_WIN = 1 * MiB, WS_WDT = 10 * MiB, WS_WOUT = 11 * MiB, WS_WGU = 15 * MiB, WS_WDN = 26 * MiB;
constexpr size_t WS_SSQ1 = 32 * MiB, WS_SSQ2 = 32 * MiB + 256 * 1024, WS_GSS = 32 * MiB + 512 * 1024, WS_DT = 33 * MiB + 512 * 1024, WS_CS = 36 * MiB, WS_WD = 39 * MiB, WS_XN = 42 * MiB, WS_QKV = 107 * MiB, WS_XC1 = 398 * MiB, WS_FFS = 464 * MiB, WS_END = 466 * MiB;

constexpr int OUT_YP = 0, OUT_YS = 33554432, OUT_KP = 33816576, OUT_VP = 34078720, OUT_CP = 34340864, OUT_SP = 34390016,
              OUT_KS = 35438592, OUT_VS = 35504128, OUT_CS = 35569664, OUT_SS = 35667968;

constexpr int LDS_BYTES = 147456, LDS_CTL = 131072 + 8192;

struct Args { const float* in[21]; float* out; unsigned char* ws; int ph_lo, ph_hi; };

typedef __bf16 bf2_t __attribute__((ext_vector_type(2)));
typedef float f2_t __attribute__((ext_vector_type(2)));
__device__ __forceinline__ unsigned pk2(float lo, float hi) { const f2_t v = {lo, hi}; return __builtin_bit_cast(unsigned, __builtin_convertvector(v, bf2_t)); }
__device__ __forceinline__ unsigned f2bf(float f) { return pk2(f, 0.f) & 0xffffu; }
__device__ __forceinline__ float bflo(unsigned u) { return __uint_as_float(u << 16); }
__device__ __forceinline__ float bfhi(unsigned u) { return __uint_as_float(u & 0xffff0000u); }
__device__ __forceinline__ float silu_f(float x) { return x * __builtin_amdgcn_rcpf(1.f + __expf(-x)); }
__device__ __forceinline__ float wave_sum(float v) {
#pragma unroll
    for (int o = 1; o < 64; o <<= 1) v += __shfl_xor(v, o);
    return v;
}
__device__ __forceinline__ float wave_max(float v) {
#pragma unroll
    for (int o = 1; o < 64; o <<= 1) v = fmaxf(v, __shfl_xor(v, o));
    return v;
}
__device__ __forceinline__ float sum8_first(float v) {
    v += __builtin_bit_cast(float, __builtin_amdgcn_update_dpp(0, __builtin_bit_cast(int, v), 0xB1, 0xF, 0xF, true));
    v += __builtin_bit_cast(float, __builtin_amdgcn_update_dpp(0, __builtin_bit_cast(int, v), 0x4E, 0xF, 0xF, true));
    v += __builtin_bit_cast(float, __builtin_amdgcn_update_dpp(0, __builtin_bit_cast(int, v), 0x104, 0xF, 0xF, true));
    return v;
}
#define LDS_WAIT() asm volatile("s_waitcnt lgkmcnt(0)" ::: "memory")
#define MFMA32(a, b, c) __builtin_amdgcn_mfma_f32_32x32x16_bf16((a), (b), (c), 0, 0, 0)

namespace pg8 {
struct EpiRes1 {
    static constexpr bool PERM = true, AFTER_DRAIN = false;
    const float* xp; const float* xs; float* out; bf16_t* hb; float* ssq;
    __device__ __forceinline__ void operator()(const f32x4 (&acc)[2][2][4][2], const Unit& u, int wr, int wc, int fr, int fq) const {
        const float* base = u.pm < 128 ? xp + (size_t)u.pm * 256 * 1024 : xs;
        bf16_t* hbo = hb + (size_t)u.pm * 256 * 1024;
        const int col0 = u.pn * BM + wc * 64 + 8 * fq;
#pragma unroll
        for (int ai = 0; ai < 2; ++ai)
#pragma unroll
            for (int m = 0; m < 4; ++m) { const int r = ai * HALF + wr * 64 + m * 16 + fr; const unsigned off = (unsigned)r * 1024u + (unsigned)col0; float ss = 0.f;
#pragma unroll
                for (int bj = 0; bj < 2; ++bj) {
                    const f32x4 v0 = __builtin_nontemporal_load((const f32x4*)(base + off + bj * 32)) + acc[ai][bj][m][0];
                    const f32x4 v1 = __builtin_nontemporal_load((const f32x4*)(base + off + bj * 32 + 4)) + acc[ai][bj][m][1];
                    ss += (v0[0] * v0[0] + v0[1] * v0[1]) + (v0[2] * v0[2] + v0[3] * v0[3]) + (v1[0] * v1[0] + v1[1] * v1[1]) + (v1[2] * v1[2] + v1[3] * v1[3]);
                    u32x4 w; w.x = cvt_pk_bf16(v0[0], v0[1]); w.y = cvt_pk_bf16(v0[2], v0[3]); w.z = cvt_pk_bf16(v1[0], v1[1]); w.w = cvt_pk_bf16(v1[2], v1[3]);
                    *(u32x4*)(hbo + off + bj * 32) = w; }
                ss += __shfl_xor(ss, 16); ss += __shfl_xor(ss, 32);
                if (fq == 0) atomicAdd(ssq + u.pm * 256 + r, ss); }
    }
};
struct EpiSwiGLU {
    static constexpr bool PERM = true, AFTER_DRAIN = false;
    const float* ssq; bf16_t* O;
    __device__ __forceinline__ void operator()(const f32x4 (&acc)[2][2][4][2], const Unit& u, int wr, int wc, int fr, int fq) const {
        const int row0 = u.pm * BM + wr * 64 + fr, col0 = u.pn * HALF + wc * 32 + 8 * fq;
#pragma unroll
        for (int ai = 0; ai < 2; ++ai)
#pragma unroll
            for (int m = 0; m < 4; ++m) { const int row = row0 + ai * HALF + m * 16; const float rstd = __builtin_amdgcn_rsqf(ssq[row] * (1.0f / 1024.0f) + 1e-6f);
                float r[8];
#pragma unroll
                for (int n = 0; n < 2; ++n)
#pragma unroll
                    for (int e = 0; e < 4; ++e) { const float gv = acc[ai][0][m][n][e] * rstd, uv = acc[ai][1][m][n][e] * rstd; r[4 * n + e] = gv * __builtin_amdgcn_rcpf(1.f + __expf(-gv)) * uv; }
                u32x4 w; w.x = cvt_pk_bf16(r[0], r[1]); w.y = cvt_pk_bf16(r[2], r[3]); w.z = cvt_pk_bf16(r[4], r[5]); w.w = cvt_pk_bf16(r[6], r[7]);
                __builtin_nontemporal_store(w, (u32x4*)(O + (size_t)row * 2816 + col0)); }
    }
};
struct EpiRes2 {
    static constexpr bool PERM = false, AFTER_DRAIN = false;
    float* out;
    __device__ __forceinline__ void operator()(const f32x4 (&acc)[2][2][4][2], const Unit& u, int wr, int wc, int fr, int fq) const {
        float* o = out + (size_t)u.pm * 256 * 1024; const int col0 = u.pn * BM + wc * 32 + 4 * fq;
#pragma unroll
        for (int ai = 0; ai < 2; ++ai)
#pragma unroll
            for (int m = 0; m < 4; ++m) { const int r = ai * HALF + wr * 64 + m * 16 + fr; const size_t off = (size_t)r * 1024 + col0;
#pragma unroll
                for (int bj = 0; bj < 2; ++bj)
#pragma unroll
                    for (int n = 0; n < 2; ++n) { f32x4* p = (f32x4*)(o + off + bj * HALF + n * 16); *p = *p + acc[ai][bj][m][n]; } }
    }
};
struct EpiFinal {
    static constexpr bool PERM = false, AFTER_DRAIN = false;
    float* out; const bf16_t* hb; const float* gfin; float* ssq2; unsigned* cnt;
    __device__ __forceinline__ void operator()(const f32x4 (&acc)[2][2][4][2], const Unit& u, int wr, int wc, int fr, int fq) const {
        typedef unsigned u32x2v __attribute__((ext_vector_type(2)));
        float* o = out + (size_t)u.pm * 256 * 1024; const bf16_t* hbo = hb + (size_t)u.pm * 256 * 1024; const int col0 = u.pn * BM + wc * 32 + 4 * fq;
        u32x2v v[2][4][2][2];
#pragma unroll
        for (int ai = 0; ai < 2; ++ai)
#pragma unroll
            for (int m = 0; m < 4; ++m) { const int r = ai * HALF + wr * 64 + m * 16 + fr; const unsigned off = (unsigned)r * 1024u + (unsigned)col0; float ss = 0.f;
#pragma unroll
                for (int bj = 0; bj < 2; ++bj)
#pragma unroll
                    for (int n = 0; n < 2; ++n) { const u32x2v hw = *(const u32x2v*)(hbo + off + bj * HALF + n * 16); f32x4 x = acc[ai][bj][m][n];
                        x[0] += __uint_as_float(hw.x << 16); x[1] += __uint_as_float(hw.x & 0xffff0000u); x[2] += __uint_as_float(hw.y << 16); x[3] += __uint_as_float(hw.y & 0xffff0000u);
                        ss += (x[0] * x[0] + x[1] * x[1]) + (x[2] * x[2] + x[3] * x[3]);
                        u32x2v w; w.x = cvt_pk_bf16(x[0], x[1]); w.y = cvt_pk_bf16(x[2], x[3]); v[ai][m][bj][n] = w; }
                ss += __shfl_xor(ss, 16); ss += __shfl_xor(ss, 32);
                if (fq == 0) atomicAdd(ssq2 + u.pm * 256 + r, ss); }
        asm volatile("s_waitcnt vmcnt(0)" ::: "memory");
        unsigned* c = cnt + 16 * u.pm;
        if ((threadIdx.x & 63) == 0) __hip_atomic_fetch_add(c, 1u, __ATOMIC_RELAXED, __HIP_MEMORY_SCOPE_AGENT);
        { unsigned sp = 0; for (;;) { const unsigned cv = (unsigned)__builtin_amdgcn_readfirstlane((int)__hip_atomic_load(c, __ATOMIC_RELAXED, __HIP_MEMORY_SCOPE_AGENT)); if (cv >= 32u) break; __builtin_amdgcn_s_sleep(2); if (++sp > (1u << 20)) break; } }
        asm volatile("" ::: "memory");
        f32x4 g[2][2];
#pragma unroll
        for (int bj = 0; bj < 2; ++bj)
#pragma unroll
            for (int n = 0; n < 2; ++n) g[bj][n] = *(const f32x4*)(gfin + col0 + bj * HALF + n * 16);
#pragma unroll
        for (int ai = 0; ai < 2; ++ai)
#pragma unroll
            for (int m = 0; m < 4; ++m) { const int r = ai * HALF + wr * 64 + m * 16 + fr; const unsigned off = (unsigned)r * 1024u + (unsigned)col0;
                const float rstd = 1.0f / sqrtf(__hip_atomic_load(ssq2 + u.pm * 256 + r, __ATOMIC_RELAXED, __HIP_MEMORY_SCOPE_AGENT) * (1.0f / 1024.0f) + 1e-6f);
#pragma unroll
                for (int bj = 0; bj < 2; ++bj)
#pragma unroll
                    for (int n = 0; n < 2; ++n) { const u32x2v w = v[ai][m][bj][n]; const f32x4 x = {__uint_as_float(w.x << 16), __uint_as_float(w.x & 0xffff0000u), __uint_as_float(w.y << 16), __uint_as_float(w.y & 0xffff0000u)};
                        __builtin_nontemporal_store(x * rstd * g[bj][n], (f32x4*)(o + off + bj * HALF + n * 16)); } }
    }
};
}

#define XB_TMO      128
#define XB_XCNT(j)  (256  + 64 * (j))
#define XB_XSUB(j)  (1280 + 64 * (j))
#define XB_XGEN(j)  (2304 + 64 * (j))
#define XB_TOP      3328
#define XB_TOPGEN   3392
#define XCD_BAR_WORDS 3456
#define XB_SPIN_CAP (1u << 18)

__device__ __forceinline__ unsigned xb_ld(unsigned* p)              { return __hip_atomic_load(p, __ATOMIC_RELAXED, __HIP_MEMORY_SCOPE_AGENT); }
__device__ __forceinline__ unsigned xb_add(unsigned* p, unsigned v) { return __hip_atomic_fetch_add(p, v, __ATOMIC_RELAXED, __HIP_MEMORY_SCOPE_AGENT); }
__device__ __forceinline__ unsigned xb_xcc_id() { return (unsigned)__builtin_amdgcn_s_getreg((3 << 11) | 20) & 0xFu; }
#define XB_SPIN(cond, bar) do { unsigned _sp = 0; while (cond) { __builtin_amdgcn_s_sleep(1); \
    if ((++_sp & 255u) == 0u) { if (xb_ld(&(bar)[XB_TMO])) break; if (_sp > XB_SPIN_CAP) { atomicAdd(&(bar)[XB_TMO], 1u); break; } } } } while (0)

struct XcdBarrier {
    unsigned* bar; unsigned x;
    volatile LAS unsigned* st;
};

__device__ __forceinline__ XcdBarrier xcd_barrier_post(unsigned* bar, volatile LAS unsigned* st) {
    XcdBarrier b; b.bar = bar; b.x = xb_xcc_id(); b.st = st;
    if (threadIdx.x == 0) (void)xb_add(&bar[XB_XCNT(b.x)], 1u);
    return b;
}
__device__ __forceinline__ void xcd_barrier_complete(unsigned* bar, unsigned x, unsigned& nloc, unsigned& nx) {
    const unsigned G = gridDim.x * gridDim.y * gridDim.z;
    unsigned sum, cnt, mine, sp = 0u;
    for (;;) {
        sum = 0u; cnt = 0u; mine = 0u;
#pragma unroll
        for (unsigned j = 0; j < 16; ++j) { const unsigned c = xb_ld(&bar[XB_XCNT(j)]); sum += c; cnt += (c > 0u) ? 1u : 0u; mine = (j == x) ? c : mine; }
        if (sum == G) break;
        __builtin_amdgcn_s_sleep(1);
        if ((++sp & 255u) == 0u) { if (xb_ld(&bar[XB_TMO])) break; if (sp > XB_SPIN_CAP) { atomicAdd(&bar[XB_TMO], 1u); break; } }
    }
    nloc = mine > 0u ? mine : 1u; nx = cnt > 0u ? cnt : 1u;
}

__device__ __forceinline__ void xcd_barrier(const XcdBarrier& b) {
    asm volatile("s_waitcnt vmcnt(0)" ::: "memory");
    __syncthreads();
    if (threadIdx.x == 0) {
        unsigned* bar = b.bar;
        __builtin_amdgcn_s_waitcnt(0);
        unsigned nloc = b.st[0], nx = b.st[1];
        if (nloc == 0u) { xcd_barrier_complete(bar, b.x, nloc, nx); b.st[0] = nloc; b.st[1] = nx; }
        const unsigned old = xb_add(&bar[XB_XSUB(b.x)], 1u);
        const unsigned gen = old / nloc;
        if (old + 1u == (gen + 1u) * nloc) {
            __builtin_amdgcn_fence(__ATOMIC_RELEASE, "agent");
            asm volatile("s_waitcnt vmcnt(0)" ::: "memory");
            const unsigned og = xb_add(&bar[XB_TOP], 1u);
            const unsigned tg = og / nx;
            if (og + 1u == (tg + 1u) * nx) xb_add(&bar[XB_TOPGEN], 1u);
            else XB_SPIN(xb_ld(&bar[XB_TOPGEN]) == tg, bar);
            __builtin_amdgcn_fence(__ATOMIC_ACQUIRE, "agent");
            xb_add(&bar[XB_XGEN(b.x)], 1u);
            asm volatile("s_waitcnt vmcnt(0)" ::: "memory");
        } else {
            XB_SPIN(xb_ld(&bar[XB_XGEN(b.x)]) == gen, bar);
            __builtin_amdgcn_fence(__ATOMIC_ACQUIRE, "agent");
            asm volatile("s_waitcnt vmcnt(0)" ::: "memory");
        }
    }
    __syncthreads();
}

struct Frame {
    LAS unsigned char* lds; int tid, lane, wave, G, bid;
    const float* in[21]; float* out; unsigned char* ws;
    bf16 *Win, *Wdt, *Wout, *Wgu, *Wdn, *XN, *QKV, *FF, *H1B; float *SSQ1, *SSQ2, *GSS, *DT, *CS, *WD; bf16 *XC0, *XC1, *FFS; unsigned* ctl;
};

__device__ __forceinline__ void transpose_item(const float* W, int ldw, int K, const float* kscale, bf16* WT, int out_row0, int n0, int k0, LAS float* scr, int lane) {
#pragma unroll 8
    for (int i = 0; i < 32; ++i) { const int kk = 2 * i + (lane >> 5); float w = W[(size_t)(k0 + kk) * ldw + n0 + (lane & 31)]; if (kscale) w *= kscale[k0 + kk]; scr[kk * 33 + (lane & 31)] = w; }
    LDS_WAIT(); asm volatile("" ::: "memory");
    const int c = lane & 7;
#pragma unroll
    for (int j = 0; j < 4; ++j) { const int n = (lane >> 3) + 8 * j; const LAS float* s = scr + (8 * c) * 33 + n;
        v4u o; o.x = pk2(s[0 * 33], s[1 * 33]); o.y = pk2(s[2 * 33], s[3 * 33]); o.z = pk2(s[4 * 33], s[5 * 33]); o.w = pk2(s[6 * 33], s[7 * 33]);
        *(v4u*)(WT + (size_t)(out_row0 + n) * K + k0 + 8 * c) = o; }
    LDS_WAIT(); asm volatile("" ::: "memory");
}
__device__ __forceinline__ void p0_prologue(Frame& F) {
    LAS float* scr = (LAS float*)(F.lds + F.wave * 16384);
    const int gw = F.bid * NWAVES + F.wave, NGW = F.G * NWAVES;
    const int gt = F.bid * NTHR + F.tid, NGT = F.G * NTHR;
    for (int i = gt; i < MROWS; i += NGT) { F.SSQ1[i] = 0.f; F.SSQ2[i] = 0.f; }
    for (int i = gt; i < MROWS * 4; i += NGT) F.GSS[i] = 0.f;
    for (int i = gt; i < 16 * 1024; i += NGT) { const int n = i >> 10, k = i & 1023; F.Wdt[i] = (bf16)f2bf(F.in[7][(size_t)k * DIN + 4608 + n]); }
    for (int it = gw; it < 16 * 144; it += NGW) {
        const int kb = it / 144, nb = it % 144, n0 = 32 * nb; const int orow = n0 < 1024 ? n0 : (n0 < 1536 ? n0 + 1024 : (n0 < 2560 ? n0 - 512 : n0));
        transpose_item(F.in[7], DIN, 1024, nullptr, F.Win, orow, n0, 64 * kb, scr, F.lane);
    }
    const f32x4* gp = (const f32x4*)F.in[6] + F.lane;
    f32x4 gv[4];
#pragma unroll
    for (int j = 0; j < 4; ++j) gv[j] = gp[64 * j];
    for (int m0 = gw; m0 < MROWS; m0 += 2 * NGW) {
        const int m1 = m0 + NGW; const bool has1 = m1 < MROWS;
        const float* xrow0 = m0 < NPR ? F.in[0] + (size_t)m0 * DM : F.in[1] + (size_t)(m0 - NPR) * DM;
        const float* xrow1 = !has1 ? xrow0 : (m1 < NPR ? F.in[0] + (size_t)m1 * DM : F.in[1] + (size_t)(m1 - NPR) * DM);
        const f32x4* xr0 = (const f32x4*)xrow0 + F.lane; const f32x4* xr1 = (const f32x4*)xrow1 + F.lane;
        f32x4 v0[4], v1[4]; float s0 = 0.f, s1 = 0.f;
#pragma unroll
        for (int j = 0; j < 4; ++j) { v0[j] = __builtin_nontemporal_load(xr0 + 64 * j); v1[j] = __builtin_nontemporal_load(xr1 + 64 * j); }
#pragma unroll
        for (int j = 0; j < 4; ++j) { s0 += (v0[j].x * v0[j].x + v0[j].y * v0[j].y) + (v0[j].z * v0[j].z + v0[j].w * v0[j].w); s1 += (v1[j].x * v1[j].x + v1[j].y * v1[j].y) + (v1[j].z * v1[j].z + v1[j].w * v1[j].w); }
        const float rstd0 = 1.0f / sqrtf(wave_sum(s0) * (1.f / DM) + EPS), rstd1 = 1.0f / sqrtf(wave_sum(s1) * (1.f / DM) + EPS);
        v2u* o0 = (v2u*)(F.XN + (size_t)m0 * DM) + F.lane;
#pragma unroll
        for (int j = 0; j < 4; ++j) { v2u w; w.x = pk2(v0[j].x * rstd0 * gv[j].x, v0[j].y * rstd0 * gv[j].y); w.y = pk2(v0[j].z * rstd0 * gv[j].z, v0[j].w * rstd0 * gv[j].w); o0[64 * j] = w; }
        if (has1) { v2u* o1 = (v2u*)(F.XN + (size_t)m1 * DM) + F.lane;
#pragma unroll
            for (int j = 0; j < 4; ++j) { v2u w; w.x = pk2(v1[j].x * rstd1 * gv[j].x, v1[j].y * rstd1 * gv[j].y); w.y = pk2(v1[j].z * rstd1 * gv[j].z, v1[j].w * rstd1 * gv[j].w); o1[64 * j] = w; } }
    }
}

__device__ __forceinline__ void p1_dt(Frame& F) {
    const int fr = F.lane & 15, fq = F.lane >> 4, w = F.wave;
    LAS float* T = (LAS float*)F.lds;
    const f32x4 bias = *(const f32x4*)(F.in[10] + 4 * fq);
    const f32x4 al = *(const f32x4*)(F.in[11] + 4 * fq);
    f32x4 av;
#pragma unroll
    for (int e = 0; e < 4; ++e) av[e] = -__expf(al[e]);
    for (int job = F.bid; job < MROWS / 128; job += F.G) {
        const int r0 = job * 128 + 16 * w;
        f32x4 acc = {0.f, 0.f, 0.f, 0.f};
        const bf16* wp = F.Wdt + (size_t)fr * 1024 + 8 * fq;
        const bf16* xp = F.XN + (size_t)(r0 + fr) * 1024 + 8 * fq;
#pragma unroll 16
        for (int kk = 0; kk < 32; ++kk) { const bf16x8 a = *(const bf16x8*)(wp + 32 * kk), b = *(const bf16x8*)(xp + 32 * kk); acc = __builtin_amdgcn_mfma_f32_16x16x32_bf16(a, b, acc, 0, 0, 0); }
        f32x4 dt, cs;
#pragma unroll
        for (int e = 0; e < 4; ++e) { const float x = acc[e] + bias[e]; const float d = x > 20.f ? x : log1pf(__expf(x)); dt[e] = d;
            float v = d * av[e];
#pragma unroll
            for (int o = 1; o < 16; o <<= 1) { const float t = __shfl_up(v, o, 16); if (fr >= o) v += t; }
            cs[e] = v; }
        if (fr == 15) *(LAS f32x4*)(T + w * 16 + 4 * fq) = cs;
        __syncthreads();
        f32x4 off = {0.f, 0.f, 0.f, 0.f}, tot = off;
#pragma unroll
        for (int q = 0; q < 4; ++q) { const int ww = (w & 4) + q; const f32x4 t = *(const LAS f32x4*)(T + ww * 16 + 4 * fq); tot += t; if (ww < w) off += t; }
        f32x4 wd;
#pragma unroll
        for (int e = 0; e < 4; ++e) { cs[e] += off[e]; wd[e] = dt[e] * __expf(tot[e] - cs[e]); }
        const size_t o = (size_t)(r0 + fr) * 16 + 4 * fq;
        *(f32x4*)(F.DT + o) = dt; *(f32x4*)(F.CS + o) = cs; *(f32x4*)(F.WD + o) = wd;
        __syncthreads();
    }
}

__device__ __forceinline__ void p2a_conv(Frame& F) {
    const int gt = F.bid * NTHR + F.tid, NGT = F.G * NTHR;
    for (int task = gt; task < 256 * 2048; task += NGT) {
        const int cgp = task & 255, seg = task >> 8, ch = cgp * 8, t0 = seg * 16;
        const bool first = (t0 & 4095) == 0;
        float w0[8], w1[8], w2[8], w3[8], cb[8];
#pragma unroll
        for (int e = 0; e < 8; ++e) { w0[e] = F.in[8][ch + e]; w1[e] = F.in[8][2048 + ch + e]; w2[e] = F.in[8][4096 + ch + e]; w3[e] = F.in[8][6144 + ch + e]; cb[e] = F.in[9][ch + e]; }
        const bf16* src = F.QKV + (size_t)t0 * NQ + X0 + ch;
        bf16* dst = (t0 < 16384 ? F.XC0 + (size_t)t0 * 2048 : F.XC1 + (size_t)(t0 - 16384) * 2048) + ch;
        float r3[8], r2[8], r1[8];
        v4u h3 = {0u, 0u, 0u, 0u}, h2 = h3, h1 = h3;
        if (!first) { h3 = *(const v4u*)(src - 3 * (size_t)NQ); h2 = *(const v4u*)(src - 2 * (size_t)NQ); h1 = *(const v4u*)(src - (size_t)NQ); }
        r3[0] = bflo(h3.x); r3[1] = bfhi(h3.x); r3[2] = bflo(h3.y); r3[3] = bfhi(h3.y); r3[4] = bflo(h3.z); r3[5] = bfhi(h3.z); r3[6] = bflo(h3.w); r3[7] = bfhi(h3.w);
        r2[0] = bflo(h2.x); r2[1] = bfhi(h2.x); r2[2] = bflo(h2.y); r2[3] = bfhi(h2.y); r2[4] = bflo(h2.z); r2[5] = bfhi(h2.z); r2[6] = bflo(h2.w); r2[7] = bfhi(h2.w);
        r1[0] = bflo(h1.x); r1[1] = bfhi(h1.x); r1[2] = bflo(h1.y); r1[3] = bfhi(h1.y); r1[4] = bflo(h1.z); r1[5] = bfhi(h1.z); r1[6] = bflo(h1.w); r1[7] = bfhi(h1.w);
        v4u rowsv[16];
#pragma unroll
        for (int l = 0; l < 16; ++l) rowsv[l] = __builtin_nontemporal_load((const v4u*)(src + (size_t)l * NQ));
#pragma unroll
        for (int l = 0; l < 16; ++l) {
            const v4u v = rowsv[l];
            float cur[8] = {bflo(v.x), bfhi(v.x), bflo(v.y), bfhi(v.y), bflo(v.z), bfhi(v.z), bflo(v.w), bfhi(v.w)};
            float o[8];
#pragma unroll
            for (int e = 0; e < 8; ++e) { const float y = w0[e] * r3[e] + w1[e] * r2[e] + w2[e] * r1[e] + w3[e] * cur[e] + cb[e]; o[e] = silu_f(y); r3[e] = r2[e]; r2[e] = r1[e]; r1[e] = cur[e]; }
            v4u ov; ov.x = pk2(o[0], o[1]); ov.y = pk2(o[2], o[3]); ov.z = pk2(o[4], o[5]); ov.w = pk2(o[6], o[7]);
            __builtin_nontemporal_store(ov, (v4u*)(dst + (size_t)l * 2048));
        }
    }
}

__device__ __forceinline__ int crow(int i, int h) { return (i & 3) + 8 * (i >> 2) + 4 * h; }
__device__ __forceinline__ void ssd_mfma_job(Frame& F, int b, int head) {
    const int tid = F.tid, lane = F.lane, wid = F.wave, r = lane & 31, h = lane >> 5, grp = head >> 2;
    LAS bf16* Xt = (LAS bf16*)F.lds;
    LAS bf16* Bn = (LAS bf16*)(F.lds + 9216);
    LAS bf16* Cn = (LAS bf16*)(F.lds + 26624);
    LAS bf16* BtS = (LAS bf16*)(F.lds + 44032);
    LAS bf16* Hb = (LAS bf16*)(F.lds + 62464);
    LAS float* Yd = (LAS float*)(F.lds + 79872);
    LAS float* Yo = (LAS float*)(F.lds + 97280);
    LAS float* csA = (LAS float*)(F.lds + 114688);
    LAS float* dtA = csA + 64;
    LAS float* Yd2 = (LAS float*)(F.lds + 115200);
    LAS float* rfA = (LAS float*)(F.lds + 123904);
    const bf16* XC = (b < 4 ? F.XC0 : F.XC1) + (size_t)((b & 3) * 4096) * 2048;
    const size_t row0 = (size_t)b * 4096;
    const float dsk = F.in[12][head];
    const bool rx = tid < 128, rb = tid >= 128 && tid < 384;
    const int xs_rseg = tid >> 3, xs_pc = tid & 7;
    const int bs_rseg = (tid - 128) >> 4, bs_pc = (tid - 128) & 15;
    const int el = tid >> 3, epg = tid & 7;
    v4u pre[4], cpre[2]; float wpre[4]; float pdt = 0.f, pcs = 0.f, pcs31 = 0.f; v4u zpre, xpre;
    f32x16 st[3];
#pragma unroll
    for (int t = 0; t < 3; ++t)
#pragma unroll
        for (int i = 0; i < 16; ++i) st[t][i] = 0.f;
    for (int i = tid; i < 17408 / 4; i += NTHR) ((LAS unsigned*)Hb)[i] = 0u;

#define SSD_PREFETCH(c) do { const int t0_ = (c) * 64; \
        if (rx) { _Pragma("unroll") for (int j = 0; j < 4; ++j) pre[j] = *(const v4u*)(XC + (size_t)(t0_ + 4 * xs_rseg + j) * 2048 + head * 64 + 8 * xs_pc); } \
        else if (rb) { _Pragma("unroll") for (int j = 0; j < 4; ++j) { pre[j] = *(const v4u*)(XC + (size_t)(t0_ + 4 * bs_rseg + j) * 2048 + 1024 + grp * 128 + 8 * bs_pc); wpre[j] = F.WD[(row0 + t0_ + 4 * bs_rseg + j) * 16 + head]; } } \
        _Pragma("unroll") for (int i = 0; i < 2; ++i) { const int id = tid + 512 * i; cpre[i] = *(const v4u*)(XC + (size_t)(t0_ + (id >> 4)) * 2048 + 1536 + grp * 128 + 8 * (id & 15)); } \
        if (tid >= 448) { pdt = F.DT[(row0 + t0_ + tid - 448) * 16 + head]; pcs = F.CS[(row0 + t0_ + tid - 448) * 16 + head]; pcs31 = F.CS[(row0 + t0_ + 31) * 16 + head]; } } while (0)
#define SSD_STAGE() do { \
        if (rx) { _Pragma("unroll") for (int e2 = 0; e2 < 4; ++e2) { v2u lo, hi; \
                _Pragma("unroll") for (int j = 0; j < 2; ++j) { const unsigned a0 = pre[2 * j][e2], a1 = pre[2 * j + 1][e2]; lo[j] = (a0 & 0xffffu) | (a1 << 16); hi[j] = (a0 >> 16) | (a1 & 0xffff0000u); } \
                *(LAS v2u*)(Xt + (8 * xs_pc + 2 * e2) * 72 + 4 * xs_rseg) = lo; *(LAS v2u*)(Xt + (8 * xs_pc + 2 * e2 + 1) * 72 + 4 * xs_rseg) = hi; } } \
        else if (rb) { _Pragma("unroll") for (int j = 0; j < 4; ++j) *(LAS v4u*)(Bn + (4 * bs_rseg + j) * 136 + 8 * bs_pc) = pre[j]; \
            _Pragma("unroll") for (int e2 = 0; e2 < 4; ++e2) { v2u lo, hi; \
                _Pragma("unroll") for (int j = 0; j < 2; ++j) { const unsigned a0 = pre[2 * j][e2], a1 = pre[2 * j + 1][e2]; \
                    lo[j] = pk2(bflo(a0) * wpre[2 * j], bflo(a1) * wpre[2 * j + 1]); hi[j] = pk2(bfhi(a0) * wpre[2 * j], bfhi(a1) * wpre[2 * j + 1]); } \
                *(LAS v2u*)(BtS + (8 * bs_pc + 2 * e2) * 72 + 4 * bs_rseg) = lo; *(LAS v2u*)(BtS + (8 * bs_pc + 2 * e2 + 1) * 72 + 4 * bs_rseg) = hi; } } \
        _Pragma("unroll") for (int i = 0; i < 2; ++i) { const int id = tid + 512 * i; *(LAS v4u*)(Cn + (id >> 4) * 136 + 8 * (id & 15)) = cpre[i]; } \
        if (tid >= 448) { dtA[tid - 448] = pdt; csA[tid - 448] = pcs; if (tid < 480) rfA[tid - 448] = __expf(pcs31 - pcs) * pdt; } } while (0)

    SSD_PREFETCH(0);
    SSD_STAGE();
    zpre = *(const v4u*)(F.QKV + (row0 + el) * NQ + Z0 + head * 64 + epg * 8);
    xpre = *(const v4u*)(XC + (size_t)el * 2048 + head * 64 + epg * 8);
    __syncthreads();
    for (int c = 0; c < 64; ++c) {
        const int t0 = c * 64;
        bf16* zp = F.QKV + (row0 + t0 + el) * NQ + Z0 + head * 64 + epg * 8;
        if (c + 1 < 64) SSD_PREFETCH(c + 1);
        if (wid < 3) {
            const int sb = wid >> 1, lb = (wid + 1) >> 1;
            f32x16 cbA, cbB;
#pragma unroll
            for (int i = 0; i < 16; ++i) { cbA[i] = 0.f; cbB[i] = 0.f; }
#pragma unroll 2
            for (int kk = 0; kk < 8; kk += 2) {
                const bf16x8 a0 = *(const LAS bf16x8*)(Bn + (32 * sb + r) * 136 + 16 * kk + 8 * h), b0 = *(const LAS bf16x8*)(Cn + (32 * lb + r) * 136 + 16 * kk + 8 * h);
                const bf16x8 a1 = *(const LAS bf16x8*)(Bn + (32 * sb + r) * 136 + 16 * kk + 16 + 8 * h), b1 = *(const LAS bf16x8*)(Cn + (32 * lb + r) * 136 + 16 * kk + 16 + 8 * h);
                cbA = MFMA32(a0, b0, cbA); cbB = MFMA32(a1, b1, cbB);
            }
            const int l = 32 * lb + r; const float csl = csA[l];
            if (sb == lb) {
#pragma unroll
                for (int ig = 0; ig < 4; ++ig) { const int s0 = 32 * sb + 8 * ig + 4 * h; const f32x4 c4 = *(const LAS f32x4*)(csA + s0), d4 = *(const LAS f32x4*)(dtA + s0);
#pragma unroll
                    for (int e = 0; e < 4; ++e) { const float f = (s0 + e) <= l ? __expf(fminf(csl - c4[e], 0.f)) * d4[e] : 0.f; cbA[4 * ig + e] = (cbA[4 * ig + e] + cbB[4 * ig + e]) * f; } }
            } else {
                const float colf = __expf(fminf(csl - csA[31], 0.f));
#pragma unroll
                for (int ig = 0; ig < 4; ++ig) { const f32x4 rf = *(const LAS f32x4*)(rfA + 8 * ig + 4 * h);
#pragma unroll
                    for (int e = 0; e < 4; ++e) cbA[4 * ig + e] = (cbA[4 * ig + e] + cbB[4 * ig + e]) * (rf[e] * colf); }
            }
            f32x16 yd0, yd1;
#pragma unroll
            for (int i = 0; i < 16; ++i) { yd0[i] = 0.f; yd1[i] = 0.f; }
#pragma unroll
            for (int stp = 0; stp < 2; ++stp) {
                v4u pw; pw.x = pk2(cbA[8 * stp + 0], cbA[8 * stp + 1]); pw.y = pk2(cbA[8 * stp + 2], cbA[8 * stp + 3]); pw.z = pk2(cbA[8 * stp + 4], cbA[8 * stp + 5]); pw.w = pk2(cbA[8 * stp + 6], cbA[8 * stp + 7]);
                const bf16x8 pf = __builtin_bit_cast(bf16x8, pw);
                const s16x4 lo0 = *(const LAS s16x4*)(Xt + r * 72 + 32 * sb + 16 * stp + 4 * h), hi0 = *(const LAS s16x4*)(Xt + r * 72 + 32 * sb + 16 * stp + 8 + 4 * h);
                const s16x4 lo1 = *(const LAS s16x4*)(Xt + (32 + r) * 72 + 32 * sb + 16 * stp + 4 * h), hi1 = *(const LAS s16x4*)(Xt + (32 + r) * 72 + 32 * sb + 16 * stp + 8 + 4 * h);
                yd0 = MFMA32(__builtin_shufflevector(lo0, hi0, 0, 1, 2, 3, 4, 5, 6, 7), pf, yd0);
                yd1 = MFMA32(__builtin_shufflevector(lo1, hi1, 0, 1, 2, 3, 4, 5, 6, 7), pf, yd1);
            }
            LAS float* dstp = (wid == 1) ? (Yd2 + r * 68) : (Yd + l * 68);
#pragma unroll
            for (int ig = 0; ig < 4; ++ig) { *(LAS f32x4*)(dstp + 8 * ig + 4 * h) = (f32x4){yd0[4 * ig], yd0[4 * ig + 1], yd0[4 * ig + 2], yd0[4 * ig + 3]};
                *(LAS f32x4*)(dstp + 32 + 8 * ig + 4 * h) = (f32x4){yd1[4 * ig], yd1[4 * ig + 1], yd1[4 * ig + 2], yd1[4 * ig + 3]}; }
        } else if (wid < 5) {
            const int lb = wid - 3, l = 32 * lb + r;
            f32x16 yo0, yo1;
#pragma unroll
            for (int i = 0; i < 16; ++i) { yo0[i] = 0.f; yo1[i] = 0.f; }
#pragma unroll 2
            for (int kk = 0; kk < 8; ++kk) {
                const bf16x8 cc = *(const LAS bf16x8*)(Cn + l * 136 + 16 * kk + 8 * h), h0 = *(const LAS bf16x8*)(Hb + r * 136 + 16 * kk + 8 * h), h1 = *(const LAS bf16x8*)(Hb + (32 + r) * 136 + 16 * kk + 8 * h);
                yo0 = MFMA32(h0, cc, yo0); yo1 = MFMA32(h1, cc, yo1);
            }
            const float elx = __expf(csA[l]);
#pragma unroll
            for (int ig = 0; ig < 4; ++ig) { *(LAS f32x4*)(Yo + l * 68 + 8 * ig + 4 * h) = (f32x4){yo0[4 * ig] * elx, yo0[4 * ig + 1] * elx, yo0[4 * ig + 2] * elx, yo0[4 * ig + 3] * elx};
                *(LAS f32x4*)(Yo + l * 68 + 32 + 8 * ig + 4 * h) = (f32x4){yo1[4 * ig] * elx, yo1[4 * ig + 1] * elx, yo1[4 * ig + 2] * elx, yo1[4 * ig + 3] * elx}; }
        } else {
            const float dec = __expf(csA[63]);
#pragma unroll
            for (int t = 0; t < 3; ++t) { const int ti = 3 * (wid - 5) + t;
                if (ti < 8) { const int pb = ti & 1, nb = ti >> 1;
#pragma unroll
                    for (int i = 0; i < 16; ++i) st[t][i] *= dec;
#pragma unroll 2
                    for (int kk = 0; kk < 4; ++kk) { const bf16x8 a = *(const LAS bf16x8*)(BtS + (32 * nb + r) * 72 + 16 * kk + 8 * h), xx = *(const LAS bf16x8*)(Xt + (32 * pb + r) * 72 + 16 * kk + 8 * h); st[t] = MFMA32(a, xx, st[t]); } } }
        }
        __syncthreads();
        {
            f32x4 a0 = *(const LAS f32x4*)(Yd + el * 68 + 8 * epg), a1 = *(const LAS f32x4*)(Yd + el * 68 + 8 * epg + 4); const f32x4 b0 = *(const LAS f32x4*)(Yo + el * 68 + 8 * epg), b1 = *(const LAS f32x4*)(Yo + el * 68 + 8 * epg + 4);
            if (el >= 32) { a0 += *(const LAS f32x4*)(Yd2 + (el - 32) * 68 + 8 * epg); a1 += *(const LAS f32x4*)(Yd2 + (el - 32) * 68 + 8 * epg + 4); }
            const float xv[8] = {bflo(xpre.x), bfhi(xpre.x), bflo(xpre.y), bfhi(xpre.y), bflo(xpre.z), bfhi(xpre.z), bflo(xpre.w), bfhi(xpre.w)};
            const float y[8] = {a0[0] + b0[0], a0[1] + b0[1], a0[2] + b0[2], a0[3] + b0[3], a1[0] + b1[0], a1[1] + b1[1], a1[2] + b1[2], a1[3] + b1[3]};
            const float z[8] = {bflo(zpre.x), bfhi(zpre.x), bflo(zpre.y), bfhi(zpre.y), bflo(zpre.z), bfhi(zpre.z), bflo(zpre.w), bfhi(zpre.w)};
            float g[8], ss = 0.f;
#pragma unroll
            for (int e = 0; e < 8; ++e) { g[e] = (y[e] + dsk * xv[e]) * silu_f(z[e]); ss += g[e] * g[e]; }
            v4u o; o.x = pk2(g[0], g[1]); o.y = pk2(g[2], g[3]); o.z = pk2(g[4], g[5]); o.w = pk2(g[6], g[7]);
            *(v4u*)zp = o;
            ss = sum8_first(ss);
            if (epg == 0) atomicAdd(F.GSS + (row0 + t0 + el) * 4 + grp, ss);
        }
        if (c + 1 < 64) {
            zpre = *(const v4u*)(F.QKV + (row0 + t0 + 64 + el) * NQ + Z0 + head * 64 + epg * 8);
            xpre = *(const v4u*)(XC + (size_t)(t0 + 64 + el) * 2048 + head * 64 + epg * 8); }
        if (wid >= 5) {
#pragma unroll
            for (int t = 0; t < 3; ++t) { const int ti = 3 * (wid - 5) + t;
                if (ti < 8) { const int pb = ti & 1, nb = ti >> 1;
#pragma unroll
                    for (int ig = 0; ig < 4; ++ig) { v2u w; w.x = pk2(st[t][4 * ig], st[t][4 * ig + 1]); w.y = pk2(st[t][4 * ig + 2], st[t][4 * ig + 3]); *(LAS v2u*)(Hb + (32 * pb + r) * 136 + 32 * nb + 8 * ig + 4 * h) = w; } } }
        }
        if (c + 1 < 64) SSD_STAGE();
        __syncthreads();
    }
#undef SSD_PREFETCH
#undef SSD_STAGE
    if (wid >= 5) {
#pragma unroll
        for (int t = 0; t < 3; ++t) { const int ti = 3 * (wid - 5) + t;
            if (ti < 8) { const int pb = ti & 1, nb = ti >> 1;
                float* so = F.out + OUT_SP + ((size_t)(b * 16 + head) * 64 + 32 * pb + r) * 128;
#pragma unroll
                for (int ig = 0; ig < 4; ++ig) *(f32x4*)(so + 32 * nb + 8 * ig + 4 * h) = (f32x4){st[t][4 * ig], st[t][4 * ig + 1], st[t][4 * ig + 2], st[t][4 * ig + 3]}; } }
    }
}

__device__ __forceinline__ void ssd_job(Frame& F, int b, int head, bool sample) {
    const int T = sample ? 16 : 4096; const int row0 = sample ? NPR + b * 16 : b * 4096;
    const int grp = head >> 2, tid = F.tid;
    LAS float* Xs = (LAS float*)F.lds;
    LAS float* Bs = Xs + 4096;
    LAS float* Cs = Bs + 8192;
    LAS float* dts = Cs + 8192;
    LAS float* dec = dts + 64;
    LAS float* Ys = dec + 64;
    const int p4 = tid >> 5, ng = tid & 31;
    float h[4][4];
    if (sample) {
#pragma unroll
        for (int i = 0; i < 4; ++i) { const f32x4 v = *(const f32x4*)(F.in[5] + ((size_t)(b * 16 + head) * 64 + 4 * p4 + i) * 128 + 4 * ng); h[i][0] = v[0]; h[i][1] = v[1]; h[i][2] = v[2]; h[i][3] = v[3]; }
    } else {
#pragma unroll
        for (int i = 0; i < 4; ++i)
#pragma unroll
            for (int j = 0; j < 4; ++j) h[i][j] = 0.f;
    }
    const float a = -__expf(F.in[11][head]), dsk = F.in[12][head];
    for (int t0 = 0; t0 < T; t0 += 64) {
        const int L = (T - t0) < 64 ? (T - t0) : 64;
        if (tid < 320) {
            const int cg8 = tid % 40, seg = tid / 40, l0 = seg * 8;
            if (l0 < L) {
                int ch; LAS float* dst; int dpitch;
                if (cg8 < 8) { ch = head * 64 + cg8 * 8; dst = Xs + cg8 * 8; dpitch = 64; }
                else if (cg8 < 24) { ch = 1024 + grp * 128 + (cg8 - 8) * 8; dst = Bs + (cg8 - 8) * 8; dpitch = 128; }
                else { ch = 1536 + grp * 128 + (cg8 - 24) * 8; dst = Cs + (cg8 - 24) * 8; dpitch = 128; }
                float w0[8], w1[8], w2[8], w3[8], cb[8];
#pragma unroll
                for (int e = 0; e < 8; ++e) { w0[e] = F.in[8][ch + e]; w1[e] = F.in[8][2048 + ch + e]; w2[e] = F.in[8][4096 + ch + e]; w3[e] = F.in[8][6144 + ch + e]; cb[e] = F.in[9][ch + e]; }
                float r3[8], r2[8], r1[8];
                auto load_row = [&](int t, float (&o)[8]) {
                    if (t >= 0) { const v4u v = *(const v4u*)(F.QKV + (size_t)(row0 + t) * NQ + X0 + ch);
                        o[0] = bflo(v.x); o[1] = bfhi(v.x); o[2] = bflo(v.y); o[3] = bfhi(v.y); o[4] = bflo(v.z); o[5] = bfhi(v.z); o[6] = bflo(v.w); o[7] = bfhi(v.w); }
                    else if (sample) { const float* sp = F.in[4] + (size_t)(b * 3 + 3 + t) * 2048 + ch;
#pragma unroll
                        for (int e = 0; e < 8; ++e) o[e] = sp[e]; }
                    else {
#pragma unroll
                        for (int e = 0; e < 8; ++e) o[e] = 0.f; }
                };
                load_row(t0 + l0 - 3, r3); load_row(t0 + l0 - 2, r2); load_row(t0 + l0 - 1, r1);
#pragma unroll
                for (int l = 0; l < 8; ++l) {
                    float cur[8];
                    if (l0 + l < L) {
                        load_row(t0 + l0 + l, cur);
#pragma unroll
                        for (int e = 0; e < 8; ++e) { const float y = w0[e] * r3[e] + w1[e] * r2[e] + w2[e] * r1[e] + w3[e] * cur[e] + cb[e]; dst[(l0 + l) * dpitch + e] = silu_f(y); }
#pragma unroll
                        for (int e = 0; e < 8; ++e) { r3[e] = r2[e]; r2[e] = r1[e]; r1[e] = cur[e]; }
                    }
                }
            }
        }
        if (tid >= 448 && tid - 448 < L) { const int l = tid - 448; const float d = F.DT[(size_t)(row0 + t0 + l) * 16 + head]; dts[l] = d; dec[l] = __expf(d * a); }
        __syncthreads();
        for (int l = 0; l < L; ++l) {
            const f32x4 xv = *(const LAS f32x4*)(Xs + l * 64 + 4 * p4);
            const f32x4 Bv = *(const LAS f32x4*)(Bs + l * 128 + 4 * ng);
            const f32x4 Cv = *(const LAS f32x4*)(Cs + l * 128 + 4 * ng);
            const float dtv = dts[l], dc = dec[l];
            float yp[4];
#pragma unroll
            for (int i = 0; i < 4; ++i) { const float xd = xv[i] * dtv; float y = 0.f;
#pragma unroll
                for (int j = 0; j < 4; ++j) { h[i][j] = dc * h[i][j] + xd * Bv[j]; y += h[i][j] * Cv[j]; }
                yp[i] = y; }
#pragma unroll
            for (int o = 16; o >= 1; o >>= 1) {
#pragma unroll
                for (int i = 0; i < 4; ++i) yp[i] += __shfl_xor(yp[i], o);
            }
            if (ng == 0) *(LAS f32x4*)(Ys + l * 64 + 4 * p4) = (f32x4){yp[0], yp[1], yp[2], yp[3]};
        }
        __syncthreads();
        {
            const int l = tid >> 3, pg = tid & 7; float ss = 0.f;
            if (l < L) {
                bf16* zp = F.QKV + (size_t)(row0 + t0 + l) * NQ + Z0 + head * 64 + pg * 8;
                const v4u zv = *(const v4u*)zp; float z[8] = {bflo(zv.x), bfhi(zv.x), bflo(zv.y), bfhi(zv.y), bflo(zv.z), bfhi(zv.z), bflo(zv.w), bfhi(zv.w)};
                float g[8];
#pragma unroll
                for (int e = 0; e < 8; ++e) { const float y = Ys[l * 64 + pg * 8 + e] + Xs[l * 64 + pg * 8 + e] * dsk; g[e] = y * silu_f(z[e]); ss += g[e] * g[e]; }
                v4u o; o.x = pk2(g[0], g[1]); o.y = pk2(g[2], g[3]); o.z = pk2(g[4], g[5]); o.w = pk2(g[6], g[7]);
                *(v4u*)zp = o;
            }
            ss += __shfl_xor(ss, 1); ss += __shfl_xor(ss, 2); ss += __shfl_xor(ss, 4);
            if (pg == 0 && l < L) atomicAdd(F.GSS + (size_t)(row0 + t0 + l) * 4 + grp, ss);
        }
        __syncthreads();
    }
    float* so = F.out + (sample ? OUT_SS : OUT_SP) + ((size_t)(b * 16 + head) * 64) * 128;
#pragma unroll
    for (int i = 0; i < 4; ++i) *(f32x4*)(so + (size_t)(4 * p4 + i) * 128 + 4 * ng) = (f32x4){h[i][0], h[i][1], h[i][2], h[i][3]};
}

constexpr int Q_SSDP = 128, Q_ATT = 2048, Q_ATS = 64;
__device__ __forceinline__ int attn_prompt_loop(Frame& F, int cur, unsigned* pollc, unsigned want) {
    const int tid = F.tid, lane = F.lane, wid = F.wave;
    LAS bf16* Ks = (LAS bf16*)F.lds;
    LAS bf16* Vt = (LAS bf16*)(F.lds + 27648);
    volatile LAS int* slot = (volatile LAS int*)(F.lds + LDS_CTL);
    const bf16* QB = F.QKV;
    const int g = wid >> 1, qh = wid & 1, r = lane & 31, h = lane >> 5;
    v4u kpre[3], vpa[2], vpb[2]; bf16x8 qpre[4];
#define ATT_LOAD(idx_) do { const int c_ = (idx_) & 63, kvh_ = ((idx_) >> 6) & 3, b_ = (idx_) >> 8; const size_t rowb_ = (size_t)b_ * 4096; const int tok0_ = (c_ - 2) * 64; \
        _Pragma("unroll") for (int i = 0; i < 3; ++i) { const int id = tid + 512 * i, rr = id >> 3, seg = id & 7, tok = tok0_ + rr; if (tok >= 0) kpre[i] = *(const v4u*)(QB + (rowb_ + tok) * NQ + K0 + kvh_ * 64 + seg * 8); } \
        _Pragma("unroll") for (int i = 0; i < 2; ++i) { const int id = tid + 512 * i; if (id < 768) { const int pr = id % 96, seg = id / 96, tok = tok0_ + 2 * pr; \
                if (tok >= 0) { vpa[i] = *(const v4u*)(QB + (rowb_ + tok) * NQ + V0 + kvh_ * 64 + seg * 8); vpb[i] = *(const v4u*)(QB + (rowb_ + tok + 1) * NQ + V0 + kvh_ * 64 + seg * 8); } } } \
        { const bf16* qp_ = QB + (rowb_ + c_ * 64 + qh * 32 + r) * NQ + Q0 + (kvh_ * 4 + g) * 64; _Pragma("unroll") for (int kk = 0; kk < 4; ++kk) qpre[kk] = *(const bf16x8*)(qp_ + 16 * kk + 8 * h); } } while (0)
    if (cur < Q_ATT) ATT_LOAD(cur);
    while (cur < Q_ATT) {
        const int c = cur & 63, kvh = (cur >> 6) & 3, b = cur >> 8;
        const int jstart = c >= 2 ? 0 : (2 - c) * 2;
        const size_t rowb = (size_t)b * 4096; const int tok0 = (c - 2) * 64;
        if (tid == 0) { slot[0] = (int)atomicAdd(F.ctl, 1u); slot[1] = (pollc && __hip_atomic_load(pollc, __ATOMIC_RELAXED, __HIP_MEMORY_SCOPE_AGENT) >= want) ? 1 : 0; }
#pragma unroll
        for (int i = 0; i < 3; ++i) { const int id = tid + 512 * i, rr = id >> 3, seg = id & 7; if (tok0 + rr >= 0) *(LAS v4u*)(Ks + rr * 72 + seg * 8) = kpre[i]; }
#pragma unroll
        for (int i = 0; i < 2; ++i) { const int id = tid + 512 * i;
            if (id < 768) { const int pr = id % 96, seg = id / 96;
                if (tok0 + 2 * pr >= 0) { LAS unsigned* vt32 = (LAS unsigned*)Vt;
#pragma unroll
                    for (int e = 0; e < 4; ++e) { const unsigned ua = vpa[i][e], ub = vpb[i][e];
                        vt32[((seg * 8 + 2 * e) * 200 + 2 * pr) >> 1] = (ua & 0xffffu) | (ub << 16);
                        vt32[((seg * 8 + 2 * e + 1) * 200 + 2 * pr) >> 1] = (ua >> 16) | (ub & 0xffff0000u); } } } }
        bf16x8 qf[4];
#pragma unroll
        for (int kk = 0; kk < 4; ++kk) qf[kk] = qpre[kk];
        const int head = kvh * 4 + g;
        bf16* qp = F.QKV + (rowb + c * 64 + qh * 32 + r) * NQ + Q0 + head * 64;
        const float sink = F.in[14][head];
        __syncthreads();
        const int nxt = slot[0]; const int stopf = slot[1];
        if (nxt < Q_ATT && !stopf) ATT_LOAD(nxt);
        f32x16 s[6];
        float mx = -INFINITY;
#pragma unroll
        for (int j = 0; j < 6; ++j) {
            if (j >= jstart) {
#pragma unroll
                for (int i = 0; i < 16; ++i) s[j][i] = 0.f;
#pragma unroll
                for (int kk = 0; kk < 4; ++kk) { const bf16x8 kf = *(const LAS bf16x8*)(Ks + (32 * j + r) * 72 + 16 * kk + 8 * h); s[j] = MFMA32(kf, qf[kk], s[j]); }
#pragma unroll
                for (int i = 0; i < 16; ++i) mx = fmaxf(mx, s[j][i]);
            }
        }
        mx = fmaxf(mx, __shfl_xor(mx, 32));
        const float m = fmaxf(mx * SCALE, sink);
        float sum = 0.f;
        f32x16 o[2];
#pragma unroll
        for (int mb = 0; mb < 2; ++mb)
#pragma unroll
            for (int i = 0; i < 16; ++i) o[mb][i] = 0.f;
#pragma unroll
        for (int j = 0; j < 6; ++j) {
            if (j >= jstart) {
#pragma unroll
                for (int i = 0; i < 16; ++i) { const float pv = __expf(s[j][i] * SCALE - m); sum += pv; s[j][i] = pv; }
#pragma unroll
                for (int st = 0; st < 2; ++st) {
                    v4u pw; pw.x = pk2(s[j][8 * st + 0], s[j][8 * st + 1]); pw.y = pk2(s[j][8 * st + 2], s[j][8 * st + 3]); pw.z = pk2(s[j][8 * st + 4], s[j][8 * st + 5]); pw.w = pk2(s[j][8 * st + 6], s[j][8 * st + 7]);
                    const bf16x8 pf = __builtin_bit_cast(bf16x8, pw);
#pragma unroll
                    for (int mb = 0; mb < 2; ++mb) { const int d = 32 * mb + r;
                        const s16x4 lo = *(const LAS s16x4*)(Vt + d * 200 + 32 * j + 16 * st + 4 * h), hi = *(const LAS s16x4*)(Vt + d * 200 + 32 * j + 16 * st + 8 + 4 * h);
                        const bf16x8 vf = __builtin_shufflevector(lo, hi, 0, 1, 2, 3, 4, 5, 6, 7);
                        o[mb] = MFMA32(vf, pf, o[mb]); }
                }
            }
        }
        sum += __shfl_xor(sum, 32);
        const float inv = 1.0f / (sum + __expf(sink - m));
#pragma unroll
        for (int mb = 0; mb < 2; ++mb)
#pragma unroll
            for (int ig = 0; ig < 4; ++ig) { v2u w; w.x = pk2(o[mb][4 * ig] * inv, o[mb][4 * ig + 1] * inv); w.y = pk2(o[mb][4 * ig + 2] * inv, o[mb][4 * ig + 3] * inv);
                *(v2u*)(qp + 32 * mb + 8 * ig + 4 * h) = w; }
        __syncthreads();
        cur = nxt;
        if (stopf) break;
    }
#undef ATT_LOAD
    return cur;
}

__device__ __forceinline__ void attn_sample_item(Frame& F, int idx) {
    const int b = idx >> 2, kvh = idx & 3, tid = F.tid, lane = F.lane, wid = F.wave, r = lane & 31, h = lane >> 5;
    LAS bf16* Ks = (LAS bf16*)F.lds;
    LAS bf16* Vt = (LAS bf16*)(F.lds + 23040);
    LAS unsigned* vt32 = (LAS unsigned*)Vt;
    const bf16* QB = F.QKV;
#pragma unroll
    for (int i = 0; i < 3; ++i) { const int id = tid + 512 * i;
        if (id < 1152) { const int j = id >> 3, seg = id & 7; v4u o;
            if (j < 128) { const float* kp = F.in[2] + ((size_t)(b * 128 + j) * 4 + kvh) * 64 + seg * 8; const f32x4 a0 = *(const f32x4*)kp, a1 = *(const f32x4*)(kp + 4);
                o.x = pk2(a0[0], a0[1]); o.y = pk2(a0[2], a0[3]); o.z = pk2(a1[0], a1[1]); o.w = pk2(a1[2], a1[3]); }
            else o = *(const v4u*)(QB + (size_t)(NPR + b * 16 + j - 128) * NQ + K0 + kvh * 64 + seg * 8);
            *(LAS v4u*)(Ks + j * 72 + seg * 8) = o; } }
#pragma unroll
    for (int i = 0; i < 2; ++i) { const int id = tid + 512 * i;
        if (id < 640) { const int pr = id % 80, seg = id / 80; v4u va, vb;
            if (pr < 64) { const float* vp = F.in[3] + ((size_t)(b * 128 + 2 * pr) * 4 + kvh) * 64 + seg * 8; const f32x4 a0 = *(const f32x4*)vp, a1 = *(const f32x4*)(vp + 4), b0 = *(const f32x4*)(vp + 256), b1 = *(const f32x4*)(vp + 260);
                va.x = pk2(a0[0], a0[1]); va.y = pk2(a0[2], a0[3]); va.z = pk2(a1[0], a1[1]); va.w = pk2(a1[2], a1[3]); vb.x = pk2(b0[0], b0[1]); vb.y = pk2(b0[2], b0[3]); vb.z = pk2(b1[0], b1[1]); vb.w = pk2(b1[2], b1[3]); }
            else if (pr < 72) { const bf16* vp = QB + (size_t)(NPR + b * 16 + 2 * pr - 128) * NQ + V0 + kvh * 64 + seg * 8; va = *(const v4u*)vp; vb = *(const v4u*)(vp + NQ); }
            else { va = (v4u){0u, 0u, 0u, 0u}; vb = va; }
#pragma unroll
            for (int e = 0; e < 4; ++e) { const unsigned ua = va[e], ub = vb[e];
                vt32[((seg * 8 + 2 * e) * 168 + 2 * pr) >> 1] = (ua & 0xffffu) | (ub << 16);
                vt32[((seg * 8 + 2 * e + 1) * 168 + 2 * pr) >> 1] = (ua >> 16) | (ub & 0xffff0000u); } } }
    __syncthreads();
    if (wid < 2) {
        const int rho = 32 * wid + r, g = rho >> 4, t = rho & 15, head = kvh * 4 + g;
        bf16* qp = F.QKV + (size_t)(NPR + b * 16 + t) * NQ + Q0 + head * 64;
        bf16x8 qf[4];
#pragma unroll
        for (int kk = 0; kk < 4; ++kk) qf[kk] = *(const bf16x8*)(qp + 16 * kk + 8 * h);
        const float sink = F.in[14][head];
        f32x16 s[5]; float mx = -INFINITY;
#pragma unroll
        for (int j = 0; j < 5; ++j) {
#pragma unroll
            for (int i = 0; i < 16; ++i) s[j][i] = 0.f;
#pragma unroll
            for (int kk = 0; kk < 4; ++kk) { const int key = j < 4 ? 32 * j + r : 128 + (r & 15); const bf16x8 kf = *(const LAS bf16x8*)(Ks + key * 72 + 16 * kk + 8 * h); s[j] = MFMA32(kf, qf[kk], s[j]); }
            if (j == 4) {
#pragma unroll
                for (int i = 0; i < 16; ++i) if (crow(i, h) >= 16) s[j][i] = -INFINITY;
            }
#pragma unroll
            for (int i = 0; i < 16; ++i) mx = fmaxf(mx, s[j][i]);
        }
        mx = fmaxf(mx, __shfl_xor(mx, 32));
        const float m = fmaxf(mx * SCALE, sink);
        float sum = 0.f; f32x16 o[2];
#pragma unroll
        for (int mb = 0; mb < 2; ++mb)
#pragma unroll
            for (int i = 0; i < 16; ++i) o[mb][i] = 0.f;
#pragma unroll
        for (int j = 0; j < 5; ++j) {
#pragma unroll
            for (int i = 0; i < 16; ++i) { const float pv = __expf(s[j][i] * SCALE - m); sum += pv; s[j][i] = pv; }
#pragma unroll
            for (int st = 0; st < 2; ++st) {
                v4u pw; pw.x = pk2(s[j][8 * st + 0], s[j][8 * st + 1]); pw.y = pk2(s[j][8 * st + 2], s[j][8 * st + 3]); pw.z = pk2(s[j][8 * st + 4], s[j][8 * st + 5]); pw.w = pk2(s[j][8 * st + 6], s[j][8 * st + 7]);
                const bf16x8 pf = __builtin_bit_cast(bf16x8, pw);
#pragma unroll
                for (int mb = 0; mb < 2; ++mb) { const int d = 32 * mb + r;
                    const s16x4 lo = *(const LAS s16x4*)(Vt + d * 168 + 32 * j + 16 * st + 4 * h), hi = *(const LAS s16x4*)(Vt + d * 168 + 32 * j + 16 * st + 8 + 4 * h);
                    const bf16x8 vf = __builtin_shufflevector(lo, hi, 0, 1, 2, 3, 4, 5, 6, 7);
                    o[mb] = MFMA32(vf, pf, o[mb]); }
            }
        }
        sum += __shfl_xor(sum, 32);
        const float inv = 1.0f / (sum + __expf(sink - m));
#pragma unroll
        for (int mb = 0; mb < 2; ++mb)
#pragma unroll
            for (int ig = 0; ig < 4; ++ig) { v2u w; w.x = pk2(o[mb][4 * ig] * inv, o[mb][4 * ig + 1] * inv); w.y = pk2(o[mb][4 * ig + 2] * inv, o[mb][4 * ig + 3] * inv);
                *(v2u*)(qp + 32 * mb + 8 * ig + 4 * h) = w; }
    }
    __syncthreads();
}

template <int EPI>
__device__ __forceinline__ void sgemm_sample(Frame& F, const bf16* A, int lda, const bf16* Bt, int K, int nItemsN, int first, int stride) {
    const int lane = F.lane, wid = F.wave, r = lane & 31, h = lane >> 5, tid = F.tid;
    LAS float* P = (LAS float*)F.lds;
    const int kper = K >> 3, k0 = wid * kper, nk = kper >> 4;
    for (int item = first; item < 4 * nItemsN; item += stride) {
        const int mi0 = item & 3, nj = item >> 2;
        int nrow0, nrow1;
        if (EPI == 3) { nrow0 = (nj >> 2) * 256 + 64 * (nj & 3); nrow1 = nrow0 + 32; } else { nrow0 = nj * 64; nrow1 = nrow0 + 32; }
        const bf16* a0 = A + (size_t)(NPR + mi0 * 64 + r) * lda + k0 + 8 * h; const bf16* a1 = a0 + (size_t)32 * lda;
        const bf16* b0 = Bt + (size_t)(nrow0 + r) * K + k0 + 8 * h; const bf16* b1 = Bt + (size_t)(nrow1 + r) * K + k0 + 8 * h;
        f32x16 acc[2][2];
#pragma unroll
        for (int ni = 0; ni < 2; ++ni)
#pragma unroll
            for (int mi = 0; mi < 2; ++mi)
#pragma unroll
                for (int i = 0; i < 16; ++i) acc[ni][mi][i] = 0.f;
#pragma unroll 4
        for (int kk = 0; kk < nk; ++kk) {
            const bf16x8 fa0 = *(const bf16x8*)(a0 + 16 * kk), fa1 = *(const bf16x8*)(a1 + 16 * kk), fb0 = *(const bf16x8*)(b0 + 16 * kk), fb1 = *(const bf16x8*)(b1 + 16 * kk);
            acc[0][0] = MFMA32(fb0, fa0, acc[0][0]); acc[0][1] = MFMA32(fb0, fa1, acc[0][1]); acc[1][0] = MFMA32(fb1, fa0, acc[1][0]); acc[1][1] = MFMA32(fb1, fa1, acc[1][1]);
        }
        LAS float* Pw = P + wid * (64 * 68);
#pragma unroll
        for (int ni = 0; ni < 2; ++ni)
#pragma unroll
            for (int mi = 0; mi < 2; ++mi)
#pragma unroll
                for (int ig = 0; ig < 4; ++ig) *(LAS f32x4*)(Pw + (32 * mi + r) * 68 + 32 * ni + 8 * ig + 4 * h) = (f32x4){acc[ni][mi][4 * ig], acc[ni][mi][4 * ig + 1], acc[ni][mi][4 * ig + 2], acc[ni][mi][4 * ig + 3]};
        __syncthreads();
        const int row = tid >> 3, grow = mi0 * 64 + row;
        if (EPI == 3) {
            const int c = (tid & 7) * 4; f32x4 g = {0.f, 0.f, 0.f, 0.f}, u = g;
#pragma unroll
            for (int w = 0; w < 8; ++w) { g += *(const LAS f32x4*)(P + w * (64 * 68) + row * 68 + c); u += *(const LAS f32x4*)(P + w * (64 * 68) + row * 68 + 32 + c); }
            const float rstd = 1.0f / sqrtf(F.SSQ1[NPR + grow] * (1.0f / 1024.0f) + EPS);
            float o[4];
#pragma unroll
            for (int e = 0; e < 4; ++e) { const float gv = g[e] * rstd, uv = u[e] * rstd; o[e] = gv * __builtin_amdgcn_rcpf(1.f + __expf(-gv)) * uv; }
            v2u w2; w2.x = pk2(o[0], o[1]); w2.y = pk2(o[2], o[3]);
            *(v2u*)(F.FFS + (size_t)grow * DFF + (nj >> 2) * 128 + 32 * (nj & 3) + c) = w2;
        } else {
            const int c0 = (tid & 7) * 8, col = nj * 64 + c0; f32x4 v0 = {0.f, 0.f, 0.f, 0.f}, v1 = v0;
#pragma unroll
            for (int w = 0; w < 8; ++w) { v0 += *(const LAS f32x4*)(P + w * (64 * 68) + row * 68 + c0); v1 += *(const LAS f32x4*)(P + w * (64 * 68) + row * 68 + c0 + 4); }
            if (EPI == 1) {
                v4u o; o.x = pk2(v0[0], v0[1]); o.y = pk2(v0[2], v0[3]); o.z = pk2(v1[0], v1[1]); o.w = pk2(v1[2], v1[3]);
                *(v4u*)(F.QKV + (size_t)(NPR + grow) * NQ + col) = o;
            } else if (EPI == 2) {
                const float* xr = F.in[1] + (size_t)grow * 1024 + col;
                v0 += *(const f32x4*)xr; v1 += *(const f32x4*)(xr + 4);
                v4u o; o.x = pk2(v0[0], v0[1]); o.y = pk2(v0[2], v0[3]); o.z = pk2(v1[0], v1[1]); o.w = pk2(v1[2], v1[3]);
                *(v4u*)(F.H1B + (size_t)(NPR + grow) * 1024 + col) = o;
                float ss = (v0[0] * v0[0] + v0[1] * v0[1]) + (v0[2] * v0[2] + v0[3] * v0[3]) + (v1[0] * v1[0] + v1[1] * v1[1]) + (v1[2] * v1[2] + v1[3] * v1[3]);
                ss += __shfl_xor(ss, 1); ss += __shfl_xor(ss, 2); ss += __shfl_xor(ss, 4);
                if ((tid & 7) == 0) atomicAdd(F.SSQ1 + NPR + grow, ss);
            } else {
                float* orow = F.out + OUT_YS + (size_t)grow * 1024 + col;
                { const v4u hw = *(const v4u*)(F.H1B + (size_t)(NPR + grow) * 1024 + col); v0 += (f32x4){bflo(hw.x), bfhi(hw.x), bflo(hw.y), bfhi(hw.y)}; v1 += (f32x4){bflo(hw.z), bfhi(hw.z), bflo(hw.w), bfhi(hw.w)}; }
                float ss = (v0[0] * v0[0] + v0[1] * v0[1]) + (v0[2] * v0[2] + v0[3] * v0[3]) + (v1[0] * v1[0] + v1[1] * v1[1]) + (v1[2] * v1[2] + v1[3] * v1[3]);
                ss += __shfl_xor(ss, 1); ss += __shfl_xor(ss, 2); ss += __shfl_xor(ss, 4);
                if ((tid & 7) == 0) atomicAdd(F.SSQ2 + NPR + grow, ss);
                asm volatile("s_waitcnt vmcnt(0)" ::: "memory");
                __syncthreads();
                unsigned* c = F.ctl + 8192 + 16 * (128 + 1 + mi0);
                if (tid == 0) { __hip_atomic_fetch_add(c, 1u, __ATOMIC_RELAXED, __HIP_MEMORY_SCOPE_AGENT);
                    unsigned sp = 0; while (__hip_atomic_load(c, __ATOMIC_RELAXED, __HIP_MEMORY_SCOPE_AGENT) < 16u) { __builtin_amdgcn_s_sleep(2); if (++sp > (1u << 20)) break; } }
                __syncthreads();
                asm volatile("" ::: "memory");
                const float rstd = 1.0f / sqrtf(__hip_atomic_load(F.SSQ2 + NPR + grow, __ATOMIC_RELAXED, __HIP_MEMORY_SCOPE_AGENT) * (1.0f / 1024.0f) + EPS);
                const f32x4 g0 = *(const f32x4*)(F.in[20] + col), g1 = *(const f32x4*)(F.in[20] + col + 4);
                *(f32x4*)orow = v0 * rstd * g0; *(f32x4*)(orow + 4) = v1 * rstd * g1;
            }
        }
        __syncthreads();
    }
}

__device__ __forceinline__ void late_weights(Frame& F) {
    LAS float* scr = (LAS float*)(F.lds + F.wave * 16384);
    const int gw = (F.bid - 128) * NWAVES + F.wave, NGW = (F.G - 128) * NWAVES;
    constexpr int I_OUT = 32 * 32, I_G = 16 * 88, I_D = 44 * 32;
    for (int it = gw; it < I_OUT + 2 * I_G + I_D; it += NGW) {
        int r = it;
        if (r < I_OUT) { const int kb = r / 32, nb = r % 32; transpose_item(F.in[15], 1024, 2048, nullptr, F.Wout, 32 * nb, 32 * nb, 64 * kb, scr, F.lane); continue; } r -= I_OUT;
        if (r < I_G) { const int kb = r / 88, nb = r % 88, n0 = 32 * nb; transpose_item(F.in[17], DFF, 1024, F.in[16], F.Wgu, (n0 >> 7) * 256 + ((n0 & 127) >> 5) * 64, n0, 64 * kb, scr, F.lane); continue; } r -= I_G;
        if (r < I_G) { const int kb = r / 88, nb = r % 88, n0 = 32 * nb; transpose_item(F.in[18], DFF, 1024, F.in[16], F.Wgu, (n0 >> 7) * 256 + ((n0 & 127) >> 5) * 64 + 32, n0, 64 * kb, scr, F.lane); continue; } r -= I_G;
        { const int kb = r / 32, nb = r % 32; transpose_item(F.in[19], 1024, DFF, nullptr, F.Wdn, 32 * nb, 32 * nb, 64 * kb, scr, F.lane); }
    }
    __syncthreads();
}
__device__ __forceinline__ void sub_arrive(Frame& F, unsigned* c) {
    asm volatile("s_waitcnt vmcnt(0)" ::: "memory");
    __syncthreads();
    if (F.tid == 0) { __builtin_amdgcn_fence(__ATOMIC_RELEASE, "agent"); asm volatile("s_waitcnt vmcnt(0)" ::: "memory"); __hip_atomic_fetch_add(c, 1u, __ATOMIC_RELAXED, __HIP_MEMORY_SCOPE_AGENT); }
}
__device__ __forceinline__ void sub_wait(Frame& F, unsigned* c, unsigned want) {
    if (F.tid == 0) {
        unsigned sp = 0; while (__hip_atomic_load(c, __ATOMIC_RELAXED, __HIP_MEMORY_SCOPE_AGENT) < want) { __builtin_amdgcn_s_sleep(2); if (++sp > (1u << 20)) break; }
        __builtin_amdgcn_fence(__ATOMIC_ACQUIRE, "agent");
        asm volatile("s_waitcnt vmcnt(0)" ::: "memory");
    }
    __syncthreads();
}
__device__ __forceinline__ void sub_barrier(Frame& F, unsigned* c, unsigned want) { sub_arrive(F, c); sub_wait(F, c, want); }
__device__ __forceinline__ void wg_arrive_wait(Frame& F, unsigned* c, unsigned want) {
    asm volatile("s_waitcnt vmcnt(0)" ::: "memory");
    __syncthreads();
    if (F.tid == 0) { __hip_atomic_fetch_add(c, 1u, __ATOMIC_RELAXED, __HIP_MEMORY_SCOPE_AGENT);
        unsigned sp = 0; while (__hip_atomic_load(c, __ATOMIC_RELAXED, __HIP_MEMORY_SCOPE_AGENT) < want) { __builtin_amdgcn_s_sleep(2); if (++sp > (1u << 20)) break; } }
    __syncthreads();
    asm volatile("" ::: "memory");
}
__device__ __forceinline__ void norm_rows(Frame& F, size_t row0, int nrows, int ch0, int cgn_log2, int grp) {
    const int cgn = 1 << cgn_log2, tid = F.tid, rows_per_pass = NTHR >> cgn_log2;
    const int cg = tid & (cgn - 1), rr = tid >> cgn_log2, ch = ch0 + 8 * cg;
    const f32x4 wa = *(const f32x4*)(F.in[13] + ch), wb = *(const f32x4*)(F.in[13] + ch + 4);
    __builtin_amdgcn_fence(__ATOMIC_ACQUIRE, "agent");
    for (int r0 = rr; r0 < nrows; r0 += 8 * rows_per_pass) {
        v4u xv[8]; float sv[8];
#pragma unroll
        for (int u = 0; u < 8; ++u) { const int r = r0 + u * rows_per_pass; if (r < nrows) { xv[u] = *(const v4u*)(F.QKV + (row0 + r) * NQ + Z0 + ch); sv[u] = F.GSS[(row0 + r) * 4 + grp]; } }
#pragma unroll
        for (int u = 0; u < 8; ++u) { const int r = r0 + u * rows_per_pass;
            if (r < nrows) { const float rstd = __builtin_amdgcn_rsqf(sv[u] * (1.0f / 256.0f) + EPS); const v4u x = xv[u];
                v4u o; o.x = pk2(bflo(x.x) * rstd * wa[0], bfhi(x.x) * rstd * wa[1]); o.y = pk2(bflo(x.y) * rstd * wa[2], bfhi(x.y) * rstd * wa[3]);
                o.z = pk2(bflo(x.z) * rstd * wb[0], bfhi(x.z) * rstd * wb[1]); o.w = pk2(bflo(x.w) * rstd * wb[2], bfhi(x.w) * rstd * wb[3]);
                *(v4u*)(F.QKV + (row0 + r) * NQ + Z0 + ch) = o; } }
    }
}
__device__ __forceinline__ void p2_mixers(Frame& F) {
    if (F.bid < Q_SSDP) {
        const int b = F.bid >> 4, head = F.bid & 15, grp = head >> 2;
        ssd_mfma_job(F, b, head);
        wg_arrive_wait(F, F.ctl + 64 + 16 * (b * 4 + grp), 4u);
        norm_rows(F, (size_t)b * 4096, 4096, head * 64, 3, grp);
    } else {
        late_weights(F);
        const int j = F.bid - Q_SSDP, b = j >> 3, grp = (j >> 1) & 3, half = j & 1;
#pragma unroll 1
        for (int hh = 0; hh < 2; ++hh) { ssd_job(F, b, grp * 4 + 2 * half + hh, true); __syncthreads(); }
        wg_arrive_wait(F, F.ctl + 12288 + 16 * (b * 4 + grp), 2u);
        norm_rows(F, (size_t)NPR + b * 16, 16, (grp * 4 + 2 * half) * 64, 4, grp);
        const int gt = j * NTHR + F.tid, NGT = (F.G - Q_SSDP) * NTHR;
        for (int i = gt; i < 8 * 128 * 256; i += NGT) { const int c = i & 255, jj = (i >> 8) & 127, bb = i >> 15; const size_t row = (size_t)bb * 4096 + 3968 + jj;
            F.out[OUT_KP + i] = bflo(F.QKV[row * NQ + K0 + c]); F.out[OUT_VP + i] = bflo(F.QKV[row * NQ + V0 + c]); }
        for (int i = gt; i < 8 * 3 * 2048; i += NGT) { const int c = i & 2047, jj = (i >> 11) % 3, bb = i / 6144; const size_t row = (size_t)bb * 4096 + 4093 + jj;
            F.out[OUT_CP + i] = bflo(F.QKV[row * NQ + X0 + c]); }
        for (int i = gt; i < 16 * 16 * 256; i += NGT) { const int c = i & 255, rr = i >> 8; const size_t row = (size_t)NPR + rr;
            F.out[OUT_KS + i] = bflo(F.QKV[row * NQ + K0 + c]); F.out[OUT_VS + i] = bflo(F.QKV[row * NQ + V0 + c]); }
        for (int i = gt; i < 16 * 3 * 2048; i += NGT) { const int c = i & 2047, jj = (i >> 11) % 3, bb = i / 6144; const size_t row = (size_t)NPR + bb * 16 + 13 + jj;
            F.out[OUT_CS + i] = bflo(F.QKV[row * NQ + X0 + c]); }
    }
    volatile LAS int* slot = (volatile LAS int*)(F.lds + LDS_CTL);
    int item = Q_ATT;
    if (F.bid >= Q_SSDP) {
        const int sb_first = F.bid - Q_SSDP, sb_n = F.G - Q_SSDP;
        __syncthreads();
        for (int it = sb_first; it < Q_ATS; it += sb_n) attn_sample_item(F, it);
        sub_arrive(F, F.ctl + 32);
        __syncthreads();
        if (F.tid == 0) slot[0] = (int)atomicAdd(F.ctl, 1u);
        __syncthreads();
        item = slot[0];
        __syncthreads();
        item = attn_prompt_loop(F, item, F.ctl + 32, (unsigned)sb_n);
        sub_wait(F, F.ctl + 32, (unsigned)sb_n);
        sgemm_sample<2>(F, F.QKV, NQ, F.Wout, 2048, 1024 / 64, sb_first, sb_n);
        sub_barrier(F, F.ctl + 32, 2u * (unsigned)sb_n);
        sgemm_sample<3>(F, F.H1B, 1024, F.Wgu, 1024, 2 * DFF / 64, sb_first, sb_n);
        sub_barrier(F, F.ctl + 32, 3u * (unsigned)sb_n);
        sgemm_sample<4>(F, F.FFS - (size_t)NPR * DFF, DFF, F.Wdn, DFF, 1024 / 64, sb_first, sb_n);
        __syncthreads();
    } else {
        __syncthreads();
        if (F.tid == 0) slot[0] = (int)atomicAdd(F.ctl, 1u);
        __syncthreads();
        item = slot[0];
        __syncthreads();
    }
    item = attn_prompt_loop(F, item, nullptr, 0u);
}

__global__ void __launch_bounds__(NTHR, 2) fwd_mega(Args args) {
    extern __shared__ __attribute__((aligned(16))) unsigned char lds[];
    Frame F;
    F.lds = (LAS unsigned char*)lds;
    F.tid = threadIdx.x; F.lane = F.tid & 63; F.wave = __builtin_amdgcn_readfirstlane(F.tid >> 6);
    F.G = gridDim.x; F.bid = blockIdx.x;
#pragma unroll
    for (int i = 0; i < 21; ++i) F.in[i] = args.in[i];
    F.out = args.out; F.ws = args.ws;
    unsigned char* ws = args.ws;
    F.ctl = (unsigned*)(ws + WS_CTL);
    F.Win = (bf16*)(ws + WS_WIN); F.Wdt = (bf16*)(ws + WS_WDT); F.Wout = (bf16*)(ws + WS_WOUT); F.Wgu = (bf16*)(ws + WS_WGU); F.Wdn = (bf16*)(ws + WS_WDN);
    F.SSQ1 = (float*)(ws + WS_SSQ1); F.SSQ2 = (float*)(ws + WS_SSQ2); F.GSS = (float*)(ws + WS_GSS); F.DT = (float*)(ws + WS_DT); F.CS = (float*)(ws + WS_CS); F.WD = (float*)(ws + WS_WD); F.XC1 = (bf16*)(ws + WS_XC1); F.FFS = (bf16*)(ws + WS_FFS);
    F.XN = (bf16*)(ws + WS_XN); F.H1B = F.XN; F.XC0 = F.XN; F.QKV = (bf16*)(ws + WS_QKV); F.FF = F.QKV;
    const int lo = args.ph_lo, hi = args.ph_hi;
    volatile LAS unsigned* MISC = (volatile LAS unsigned*)(F.lds + LDS_CTL + 64);
    if (F.tid < 2) MISC[F.tid] = 0u;
    __syncthreads();
    XcdBarrier bar; bar.bar = F.ctl + 1024; bar.x = 0; bar.st = MISC;
    if (hi - lo > 1) bar = xcd_barrier_post(F.ctl + 1024, MISC);
#define IN(k) (lo <= (k) && (k) < hi)
#define SEAM(k) do { if (IN(k) && IN((k) + 1)) { xcd_barrier(bar); } } while (0)
    if (lo < 0) cg::this_grid().sync();

    if (IN(0)) { p0_prologue(F); } SEAM(0);
    if (IN(1)) {
        pg8::Gemm g{F.XN, F.Win, NPR, NQ, 1024, 1024}; pg8::StaticOrder S; S.init(NPR, NQ, F.G, F.bid);
        pg8::EpiBf16<0> E{F.QKV, NQ, nullptr, 0, 0, 1.f};
        const bool side_first = ((F.bid >> 3) & 1) != 0;
        if (side_first) { sgemm_sample<1>(F, F.XN, 1024, F.Win, 1024, NQ / 64, F.bid, F.G); p1_dt(F); }
        pg8::gemm_phase<pg8::EpiBf16<0>, pg8::StaticOrder, true, true>(F.lds, g, S, E);
        if (!side_first) { sgemm_sample<1>(F, F.XN, 1024, F.Win, 1024, NQ / 64, F.bid, F.G); p1_dt(F); }
    } SEAM(1);
    if (IN(2)) { p2a_conv(F); } SEAM(2);
    if (IN(3)) { p2_mixers(F); } SEAM(3);
    if (IN(4)) {
        pg8::Gemm g{F.QKV, F.Wout, NPR, 1024, 2048, NQ}; pg8::StaticOrder S; S.init(NPR, 1024, F.G, F.bid);
        pg8::EpiRes1 E{F.in[0], F.in[1], F.out, F.H1B, F.SSQ1};
        pg8::gemm_phase<pg8::EpiRes1, pg8::StaticOrder, true, true>(F.lds, g, S, E);
    } SEAM(4);
    if (IN(5)) {
        pg8::Gemm g{F.H1B, F.Wgu, NPR, 2 * DFF, 1024, 1024}; pg8::StaticOrder S; S.init(NPR, 2 * DFF, F.G, F.bid);
        pg8::EpiSwiGLU E{F.SSQ1, F.FF};
        pg8::gemm_phase<pg8::EpiSwiGLU, pg8::StaticOrder, true, true>(F.lds, g, S, E);
    } SEAM(5);
    if (IN(6)) {
        pg8::Gemm g{F.FF, F.Wdn, NPR, 1024, DFF, DFF}; pg8::StaticOrder S; S.init(NPR, 1024, F.G, F.bid);
        pg8::EpiFinal E{F.out, F.H1B, F.in[20], F.SSQ2, F.ctl + 8192};
        pg8::gemm_phase<pg8::EpiFinal, pg8::StaticOrder, true, true>(F.lds, g, S, E);
    }
#undef IN
#undef SEAM
}

extern "C" void kernel_launch(void* const* d_in, const int* in_sizes, int n_in, void* d_out, int out_size, void* d_ws, size_t ws_size, hipStream_t stream) {
    static int grid = 0;
    if (grid == 0) {
        if (n_in != 21 || ws_size < WS_END) { fprintf(stderr, "kernel_launch: unexpected n_in %d / ws %zu\n", n_in, ws_size); grid = -1; return; }
        int dev = 0, cus = 0, per_cu = 0;
        hipGetDevice(&dev); hipDeviceGetAttribute(&cus, hipDeviceAttributeMultiprocessorCount, dev);
        if (hipFuncSetAttribute((const void*)fwd_mega, hipFuncAttributeMaxDynamicSharedMemorySize, LDS_BYTES) != hipSuccess) { fprintf(stderr, "kernel_launch: hipFuncSetAttribute failed\n"); grid = -1; return; }
        if (hipOccupancyMaxActiveBlocksPerMultiprocessor(&per_cu, (const void*)fwd_mega, NTHR, LDS_BYTES) != hipSuccess || per_cu < 1) { fprintf(stderr, "kernel_launch: occupancy query says %d\n", per_cu); per_cu = 1; }
        (void)hipGetLastError();
        grid = cus * per_cu;
        fprintf(stderr, "kernel_launch: grid %d (cus %d x %d)\n", grid, cus, per_cu);
    }
    if (grid < 0) return;
    if (hipMemsetAsync((char*)d_ws + WS_CTL, 0, 65536, stream) != hipSuccess) { fprintf(stderr, "kernel_launch: memset failed\n"); return; }
    Args a{};
    for (int i = 0; i < 21; ++i) a.in[i] = (const float*)d_in[i];
    a.out = (float*)d_out; a.ws = (unsigned char*)d_ws;
#if MK_MULTI
    for (int ph = 0; ph < NPHASE; ++ph) { a.ph_lo = ph; a.ph_hi = ph + 1; hipLaunchKernelGGL(fwd_mega, dim3(grid), dim3(NTHR), LDS_BYTES, stream, a); }
#else
    a.ph_lo = 0; a.ph_hi = NPHASE;
    void* kargs[] = {&a};
    hipError_t e = hipLaunchCooperativeKernel((const void*)fwd_mega, dim3(grid), dim3(NTHR), kargs, LDS_BYTES, stream);
    if (e != hipSuccess) fprintf(stderr, "kernel_launch: cooperative launch failed: %s (grid %d)\n", hipGetErrorString(e), grid);
#endif
}
```
